# Optimizing an MI355X kernel written in HIP

```python
import math, functools
import jax, jax.numpy as jnp
from jax import lax
import numpy as np

D_MODEL = 1024
BATCH = 8
SEQ = 4096
DEPTH = 2
DEC_BATCH = 32
DEC_SEQ = 4
PAST_LEN = 16384
PAGE_SIZE = 128

D_ATT = D_MODEL // 2
D_SSM = D_MODEL - D_ATT
HEAD_DIM = 64
N_HEADS = D_ATT // HEAD_DIM
SSM_GROUP = 16
N_SSM_GROUPS = D_SSM // SSM_GROUP
SSM_STATE = 64
BRANCHES = ((128, 1), (512, 4), (2048, 16))
W_MAX = max(w for w, _ in BRANCHES)
N_BUCKETS = 32
MAX_DISTANCE = W_MAX
D_FF = ((8 * D_MODEL // 3 + 127) // 128) * 128
D_PLE = 256
D_IN = 3 * D_ATT + D_SSM
BLOCK_Q = 128
EPS = 1e-6
NEG = -1e30

kernel_name = 'hybrid_dilated_attn_s5_decoder_step'


def rmsnorm(x, g):
    xf = x.astype(jnp.float32)
    y = xf * lax.rsqrt(jnp.mean(xf * xf, axis=-1, keepdims=True) + EPS)
    return (y * g.astype(jnp.float32)).astype(x.dtype)


def swiglu(x, wg, wu, wd):
    return (jax.nn.silu(x @ wg) * (x @ wu)) @ wd


def t5_bucket(dist):
    dist = np.asarray(dist, dtype=np.int64)
    exact = N_BUCKETS // 2
    ratio = np.log(np.maximum(dist, 1) / exact) / np.log(MAX_DISTANCE / exact)
    large = np.minimum(exact + (ratio * (N_BUCKETS - exact)).astype(np.int64), N_BUCKETS - 1)
    return np.where(dist < exact, dist, large).astype(np.int32)


def branch_bias(rel_bias, window, dilation):
    n = window // dilation
    return rel_bias[t5_bucket(np.arange(n + 1) * dilation)].T.astype(jnp.float32)


def softmax_stats(logits):
    m = jnp.max(logits, axis=-1, keepdims=True)
    e = jnp.exp(logits - m)
    s = jnp.sum(e, axis=-1, keepdims=True)
    return e / s, (m + jnp.log(s))[..., 0]


def _strided(t, d):
    b, s = t.shape[:2]
    return t.reshape(b, s // d, d, *t.shape[2:]).swapaxes(1, 2).reshape(b * d, s // d, *t.shape[2:])


def _unstrided(t, b, d):
    ls = t.shape[1]
    return t.reshape(b, d, ls, *t.shape[2:]).swapaxes(1, 2).reshape(b, ls * d, *t.shape[2:])


def dilated_branch_prompt(q, k, v, bias, d, n):
    bsz = q.shape[0]
    qs, ks, vs = _strided(q, d), _strided(k, d), _strided(v, d)
    nseq, ls = qs.shape[:2]
    bq = min(BLOCK_Q, ls)
    nb = -(-ls // bq)
    lp = nb * bq
    qs = jnp.pad(qs, ((0, 0), (0, lp - ls), (0, 0), (0, 0)))
    ks = jnp.pad(ks, ((0, 0), (n, lp - ls), (0, 0), (0, 0)))
    vs = jnp.pad(vs, ((0, 0), (n, lp - ls), (0, 0), (0, 0)))
    idx = np.arange(nb)[:, None] * bq + np.arange(bq + n)[None, :]
    kb, vb = ks[:, idx], vs[:, idx]
    qb = qs.reshape(nseq, nb, bq, N_HEADS, HEAD_DIM)
    logits = jnp.einsum('nbqhd,nbkhd->nbhqk', qb, kb,
                        preferred_element_type=jnp.float32) / math.sqrt(HEAD_DIM)
    step = np.arange(bq)[:, None] - np.arange(bq + n)[None, :] + n
    valid = ((step >= 0) & (step <= n))[None] & (idx - n >= 0)[:, None, :]
    logits = logits + bias[:, np.clip(step, 0, n)][None, None]
    logits = jnp.where(valid[None, :, None], logits, NEG)
    probs, lse = softmax_stats(logits)
    o = jnp.einsum('nbhqk,nbkhd->nbqhd', probs, vb.astype(jnp.float32))
    o = o.reshape(nseq, lp, N_HEADS, HEAD_DIM)[:, :ls]
    lse = lse.transpose(0, 1, 3, 2).reshape(nseq, lp, N_HEADS)[:, :ls]
    return _unstrided(o, bsz, d), _unstrided(lse, bsz, d)


def dilated_branch_sample(q, k_ext, v_ext, bias, d, n):
    t_new = q.shape[1]
    past = k_ext.shape[1] - t_new
    idx = past + np.arange(t_new)[:, None] - np.arange(n + 1)[None, :] * d
    valid = idx >= 0
    idx = np.maximum(idx, 0)
    kg, vg = k_ext[:, idx], v_ext[:, idx]
    logits = jnp.einsum('bthd,btkhd->bhtk', q, kg,
                        preferred_element_type=jnp.float32) / math.sqrt(HEAD_DIM)
    logits = logits + bias[None, :, None, :]
    logits = jnp.where(valid[None, None], logits, NEG)
    probs, lse = softmax_stats(logits)
    o = jnp.einsum('bhtk,btkhd->bthd', probs, vg.astype(jnp.float32))
    return o, lse.transpose(0, 2, 1)


def merge_branches(outs, lses):
    w = jax.nn.softmax(jnp.stack(lses, axis=0), axis=0)
    return jnp.sum(w[..., None] * jnp.stack(outs, axis=0), axis=0)


def attend_prompt(q, k, v, rel_bias):
    outs, lses = [], []
    for window, dil in BRANCHES:
        o, l = dilated_branch_prompt(q, k, v, branch_bias(rel_bias, window, dil), dil, window // dil)
        outs.append(o)
        lses.append(l)
    keep = min(W_MAX, q.shape[1])
    return merge_branches(outs, lses), k[:, -keep:], v[:, -keep:]


def attend_sample(q, k, v, rel_bias, cache_k, cache_v):
    buf = cache_k.shape[1]
    k_ext = jnp.concatenate([cache_k.astype(k.dtype), k], axis=1)
    v_ext = jnp.concatenate([cache_v.astype(v.dtype), v], axis=1)
    outs, lses = [], []
    for window, dil in BRANCHES:
        o, l = dilated_branch_sample(q, k_ext, v_ext, branch_bias(rel_bias, window, dil), dil, window // dil)
        outs.append(o)
        lses.append(l)
    return merge_branches(outs, lses), k_ext[:, -buf:], v_ext[:, -buf:]


def s5_mixer(u, h0, a_re, a_im, log_dt, b_re, b_im, c_re, c_im, d_skip, w_glu, b_glu):
    f32 = jnp.float32
    bsz, seq, _ = u.shape
    uf = u.astype(f32)
    lam = lax.complex(a_re.astype(f32), a_im.astype(f32))
    dt = jnp.exp(log_dt.astype(f32))[:, None]
    abar = jnp.exp(lam * dt)
    bbar = ((abar - 1.0) / lam)[:, :, None] * lax.complex(b_re.astype(f32), b_im.astype(f32))
    ug = uf.reshape(bsz, seq, N_SSM_GROUPS, SSM_GROUP).astype(jnp.complex64)
    bu = jnp.einsum('blgi,gni->blgn', ug, bbar)
    bu = bu.at[:, 0].add(abar * h0)
    a = jnp.broadcast_to(abar, (1, seq) + abar.shape)

    def combine(left, right):
        a_l, b_l = left
        a_r, b_r = right
        return a_r * a_l, a_r * b_l + b_r

    _, h = lax.associative_scan(combine, (a, bu), axis=1)
    c = lax.complex(c_re.astype(f32), c_im.astype(f32))
    y = jnp.real(jnp.einsum('blgn,gon->blgo', h, c)).reshape(bsz, seq, D_SSM) + d_skip.astype(f32) * uf
    z = jax.nn.gelu(y)
    out = z * jax.nn.sigmoid(z @ w_glu.astype(f32) + b_glu.astype(f32))
    return out.astype(u.dtype), h[:, -1]


def trunk_layer(x, p, lw, rel_bias, attend, h0):
    bsz, seq, _ = x.shape
    h = rmsnorm(x, lw['norm_ffn'][0])
    x = x + 0.5 * swiglu(h, lw['ffn_w_gate'][0], lw['ffn_w_up'][0], lw['ffn_w_down'][0])
    h = rmsnorm(x, lw['norm_mix'])
    q, k, v, u = jnp.split(h @ lw['w_in'], [D_ATT, 2 * D_ATT, 3 * D_ATT], axis=-1)
    heads = (bsz, seq, N_HEADS, HEAD_DIM)
    att, k_state, v_state = attend(q.reshape(heads), k.reshape(heads), v.reshape(heads), rel_bias)
    ssm, h_last = s5_mixer(u, h0, lw['ssm_a_re'], lw['ssm_a_im'], lw['ssm_log_dt'], lw['ssm_b_re'],
                           lw['ssm_b_im'], lw['ssm_c_re'], lw['ssm_c_im'], lw['ssm_d'], lw['w_glu'], lw['b_glu'])
    mixed = jnp.concatenate([rmsnorm(att.reshape(bsz, seq, D_ATT).astype(x.dtype), lw['norm_att_out']),
                             rmsnorm(ssm, lw['norm_ssm_out'])], axis=-1)
    x = x + mixed @ lw['w_out']
    h = rmsnorm(x, lw['norm_ffn'][1])
    x = x + 0.5 * swiglu(h, lw['ffn_w_gate'][1], lw['ffn_w_up'][1], lw['ffn_w_down'][1])
    gate = jax.nn.sigmoid(rmsnorm(x, lw['norm_ple']) @ lw['w_ple_gate'])
    x = x + gate * (p.astype(x.dtype) @ lw['w_ple_proj'])
    return x, k_state, v_state, h_last


def setup_inputs(seed: int = 0) -> dict:
    key = jax.random.key(seed)
    ks = iter(jax.random.split(key, 40))
    f32 = jnp.float32

    def nrm(shape, scale):
        return scale * jax.random.normal(next(ks), shape, f32)

    def gain(shape):
        return 1.0 + 0.05 * jax.random.normal(next(ks), shape, f32)

    cache_len = min(W_MAX, PAST_LEN)
    G, N, I = N_SSM_GROUPS, SSM_STATE, SSM_GROUP
    return {
        'x_prompt': nrm((BATCH, SEQ, D_MODEL), 1.0),
        'x_sample': nrm((DEC_BATCH, DEC_SEQ, D_MODEL), 1.0),
        'p_prompt': nrm((DEPTH, BATCH, SEQ, D_PLE), 1.0),
        'p_sample': nrm((DEPTH, DEC_BATCH, DEC_SEQ, D_PLE), 1.0),
        'cache_k': nrm((DEPTH, DEC_BATCH, cache_len, N_HEADS, HEAD_DIM), 1.0),
        'cache_v': nrm((DEPTH, DEC_BATCH, cache_len, N_HEADS, HEAD_DIM), 1.0),
        'state_ssm_re': nrm((DEPTH, DEC_BATCH, G, N), 0.1),
        'state_ssm_im': nrm((DEPTH, DEC_BATCH, G, N), 0.1),
        'rel_bias': nrm((N_BUCKETS, N_HEADS), 0.5),
        'w_in': nrm((DEPTH, D_MODEL, D_IN), D_MODEL ** -0.5),
        'w_out': nrm((DEPTH, D_MODEL, D_MODEL), D_MODEL ** -0.5),
        'norm_mix': gain((DEPTH, D_MODEL)),
        'norm_att_out': gain((DEPTH, D_ATT)),
        'norm_ssm_out': gain((DEPTH, D_SSM)),
        'norm_ffn': gain((DEPTH, 2, D_MODEL)),
        'ffn_w_gate': nrm((DEPTH, 2, D_MODEL, D_FF), D_MODEL ** -0.5),
        'ffn_w_up': nrm((DEPTH, 2, D_MODEL, D_FF), D_MODEL ** -0.5),
        'ffn_w_down': nrm((DEPTH, 2, D_FF, D_MODEL), D_FF ** -0.5),
        'ssm_a_re': -0.5 * jnp.exp(nrm((DEPTH, G, N), 0.02)),
        'ssm_a_im': jnp.pi * jnp.arange(N, dtype=f32)[None, None, :] + nrm((DEPTH, G, N), 0.02),
        'ssm_log_dt': jax.random.uniform(next(ks), (DEPTH, G), f32, math.log(1e-3), math.log(1e-1)),
        'ssm_b_re': nrm((DEPTH, G, N, I), (2 * I) ** -0.5),
        'ssm_b_im': nrm((DEPTH, G, N, I), (2 * I) ** -0.5),
        'ssm_c_re': nrm((DEPTH, G, I, N), (2 * N) ** -0.5),
        'ssm_c_im': nrm((DEPTH, G, I, N), (2 * N) ** -0.5),
        'ssm_d': nrm((DEPTH, D_SSM), 1.0),
        'w_glu': nrm((DEPTH, D_SSM, D_SSM), D_SSM ** -0.5),
        'b_glu': nrm((DEPTH, D_SSM), 0.01),
        'norm_ple': gain((DEPTH, D_MODEL)),
        'w_ple_gate': nrm((DEPTH, D_MODEL, D_MODEL), D_MODEL ** -0.5),
        'w_ple_proj': nrm((DEPTH, D_PLE, D_MODEL), D_PLE ** -0.5),
        'norm_final': gain((D_MODEL,)),
    }


def reference(x_prompt, x_sample, p_prompt, p_sample, cache_k, cache_v, state_ssm_re, state_ssm_im,
              rel_bias, w_in, w_out, norm_mix, norm_att_out, norm_ssm_out, norm_ffn, ffn_w_gate,
              ffn_w_up, ffn_w_down, ssm_a_re, ssm_a_im, ssm_log_dt, ssm_b_re, ssm_b_im, ssm_c_re,
              ssm_c_im, ssm_d, w_glu, b_glu, norm_ple, w_ple_gate, w_ple_proj, norm_final):
    f32 = jnp.float32
    xp, xs = x_prompt, x_sample
    kp, vp, rp, ip = [], [], [], []
    kss, vss, rss, iss = [], [], [], []
    for i in range(DEPTH):
        lw = dict(w_in=w_in[i], w_out=w_out[i], norm_mix=norm_mix[i], norm_att_out=norm_att_out[i],
                  norm_ssm_out=norm_ssm_out[i], norm_ffn=norm_ffn[i], ffn_w_gate=ffn_w_gate[i],
                  ffn_w_up=ffn_w_up[i], ffn_w_down=ffn_w_down[i], ssm_a_re=ssm_a_re[i],
                  ssm_a_im=ssm_a_im[i], ssm_log_dt=ssm_log_dt[i], ssm_b_re=ssm_b_re[i],
                  ssm_b_im=ssm_b_im[i], ssm_c_re=ssm_c_re[i], ssm_c_im=ssm_c_im[i], ssm_d=ssm_d[i],
                  w_glu=w_glu[i], b_glu=b_glu[i], norm_ple=norm_ple[i], w_ple_gate=w_ple_gate[i],
                  w_ple_proj=w_ple_proj[i])
        h0p = jnp.zeros((xp.shape[0], N_SSM_GROUPS, SSM_STATE), jnp.complex64)
        xp, k_new, v_new, h_last = trunk_layer(xp, p_prompt[i], lw, rel_bias, attend_prompt, h0p)
        kp.append(k_new)
        vp.append(v_new)
        rp.append(jnp.real(h_last))
        ip.append(jnp.imag(h_last))
        h0s = lax.complex(state_ssm_re[i].astype(f32), state_ssm_im[i].astype(f32))
        attend_s = functools.partial(attend_sample, cache_k=cache_k[i], cache_v=cache_v[i])
        xs, k_new, v_new, h_last = trunk_layer(xs, p_sample[i], lw, rel_bias, attend_s, h0s)
        kss.append(k_new)
        vss.append(v_new)
        rss.append(jnp.real(h_last))
        iss.append(jnp.imag(h_last))
    y_prompt = rmsnorm(xp, norm_final)
    y_sample = rmsnorm(xs, norm_final)
    return (y_prompt, y_sample, jnp.stack(kp), jnp.stack(vp), jnp.stack(rp), jnp.stack(ip),
            jnp.stack(kss), jnp.stack(vss), jnp.stack(rss), jnp.stack(iss))
```

```cpp
#include <hip/hip_runtime.h>
#include <hip/hip_bf16.h>
#include <hip/hip_cooperative_groups.h>
#include <cstdio>
namespace cg = cooperative_groups;

typedef unsigned short u16;
using bf16x8 = __attribute__((ext_vector_type(8))) short;
using f32x4 = __attribute__((ext_vector_type(4))) float;

constexpr int P_ROWS = 32768, S_ROWS = 128, M_ROWS = 32896, M_PAD = 33024;
constexpr int DM = 1024, DFF = 2816, DIN = 2048, DH = 512, DPLE = 256;
constexpr int SEQ = 4096;
constexpr float EPS = 1e-6f;

constexpr size_t O_YP = 0;
constexpr size_t O_YS = 33554432;
constexpr size_t O_KP = O_YS + 131072;
constexpr size_t O_VP = O_KP + 16777216;
constexpr size_t O_RP = O_VP + 16777216;
constexpr size_t O_IP = O_RP + 32768;
constexpr size_t O_KS = O_IP + 32768;
constexpr size_t O_VS = O_KS + 67108864;
constexpr size_t O_RS = O_VS + 67108864;
constexpr size_t O_IS = O_RS + 131072;

constexpr size_t LW_GU0 = 0, LW_D0 = 5767168, LW_GU1 = 8650752, LW_D1 = 14417920, LW_IN = 17301504,
                 LW_OUT = 19398656, LW_PG = 20447232, LW_PP = 21495808, LW_GLU = 21757952, LW_SIZE = 22020096;

constexpr size_t WS_W = 0;
constexpr size_t WS_X = WS_W + 2 * LW_SIZE * 2;
constexpr size_t WS_H = WS_X + (size_t)M_PAD * DM * 4;
constexpr size_t WS_MIX = WS_H + (size_t)M_PAD * DM * 2;
constexpr size_t WS_ACT = WS_MIX + (size_t)M_PAD * DM * 2;
constexpr size_t WS_Q = WS_ACT + (size_t)M_PAD * DFF * 2;
constexpr size_t WS_K = WS_Q + (size_t)M_PAD * DH * 2;
constexpr size_t WS_V = WS_K + (size_t)M_PAD * DH * 2;
constexpr size_t WS_U = WS_V + (size_t)M_PAD * DH * 2;
constexpr size_t WS_O = WS_U + (size_t)M_PAD * DH * 2;
constexpr size_t WS_LSE = WS_O + (size_t)3 * M_PAD * DH * 2;
constexpr size_t WS_YL = WS_LSE + (size_t)3 * M_PAD * 8 * 4;
constexpr size_t WS_Z = WS_YL + (size_t)M_PAD * DH * 4;
constexpr size_t WS_PBF = WS_Z + (size_t)M_PAD * DH * 2;
constexpr size_t WS_E = WS_PBF + (size_t)M_PAD * DPLE * 2;
constexpr size_t WS_ABAR = WS_E + (size_t)8 * 32 * 32 * 128 * 4;
constexpr size_t WS_ABART = WS_ABAR + 2 * 32 * 64 * 2 * 4;
constexpr size_t WS_BMT = WS_ABART + 2 * 32 * 64 * 2 * 4;
constexpr size_t WS_CMT = WS_BMT + 2 * 32 * 128 * 16 * 2;
constexpr size_t WS_BIAS = WS_CMT + 2 * 32 * 16 * 128 * 2;
constexpr size_t WS_RSS = WS_BIAS + 3 * 8 * 132 * 4 + 64;
constexpr size_t WS_PTRS = WS_RSS + (size_t)8 * M_PAD * 32 * 4;
constexpr size_t WS_BAR = WS_PTRS + 512;
constexpr size_t WS_END = WS_BAR + 16384;

constexpr int LDS_BYTES = 131072;

struct Params {
  const float* in[32];
  float* out;
  unsigned char* ws;
};

struct EpiArgs {
  const float* xp; const float* xs; float* xout;
  const float* aux; float* fout; const float* fin;
  u16* b0; u16* b1; u16* b2; u16* b3; const u16* zin;
  const float* rss_in; float* rss_out; const float* gain_out; u16* hout;
  float* out; float scale; int layer;
};

__device__ __forceinline__ unsigned pk2(float lo, float hi) { unsigned r; asm("v_cvt_pk_bf16_f32 %0, %1, %2" : "=v"(r) : "v"(lo), "v"(hi)); return r; }
__device__ __forceinline__ u16 f2bf(float f) { return (u16)(pk2(f, 0.f) & 0xffffu); }
__device__ __forceinline__ float bf2f(u16 h) { return __uint_as_float(((unsigned)h) << 16); }
__device__ __forceinline__ float sigmoidf_(float x) { return __builtin_amdgcn_rcpf(1.f + __expf(-x)); }
__device__ __forceinline__ float gelu_tanh(float x) {
  float t = 0.7978845608028654f * (x + 0.044715f * x * x * x);
  return x * __builtin_amdgcn_rcpf(1.f + __expf(-2.f * t));
}
__device__ __forceinline__ float wave_sum(float v) {
  for (int o = 32; o > 0; o >>= 1) v += __shfl_xor(v, o);
  return v;
}
__device__ __forceinline__ float wave_max(float v) {
  for (int o = 32; o > 0; o >>= 1) v = fmaxf(v, __shfl_xor(v, o));
  return v;
}
__device__ __forceinline__ int launder_v(int x) { asm volatile("" : "+v"(x)); return x; }
__device__ __forceinline__ int launder_s(int x) { x = __builtin_amdgcn_readfirstlane(x); asm volatile("" : "+s"(x)); return x; }
__device__ __forceinline__ unsigned char* launder_p(unsigned char* x) {
  unsigned long long v = (unsigned long long)x;
  unsigned lo = __builtin_amdgcn_readfirstlane((unsigned)v), hi = __builtin_amdgcn_readfirstlane((unsigned)(v >> 32));
  asm volatile("" : "+s"(lo), "+s"(hi));
  return (unsigned char*)(((unsigned long long)hi << 32) | lo);
}
#define IDS() const int TID = launder_v(threadIdx.x); const int BID = launder_s(blockIdx.x); const int GDIM = launder_s(gridDim.x); (void)TID; (void)BID; (void)GDIM
#define LDS_FENCE() asm volatile("s_waitcnt lgkmcnt(0)" ::: "memory")

enum { EPI_GU = 0, EPI_RES = 1, EPI_QKVU = 2, EPI_GLU = 3, EPI_PROJ = 4, EPI_PLE = 5 };
#define LAS __attribute__((address_space(3)))
constexpr int BM = 256, BK = 64, HALF = 128, HTB = HALF * BK * 2;

__device__ __forceinline__ int lds_byte(int r, int c) { const int st = (r >> 4) * 2 + (c >> 5), rr = r & 15, cc = c & 31, ob = rr * 64 + cc * 2; return st * 1024 + (ob ^ (((ob >> 9) & 1) << 5)); }
__device__ __forceinline__ void stage_rc(int b, int& R, int& C) { const int st = b / 1024, sb = b % 1024, swz = sb ^ (((sb >> 9) & 1) << 5); R = (st >> 1) * 16 + swz / 64; C = (st & 1) * 32 + (swz % 64) / 2; }

struct Unit { int pm, pn; };
struct Sched {
  int nN, nwg, G, c;
  __device__ __forceinline__ void init(int N) { nN = N >> 8; nwg = 128 * nN; G = gridDim.x; c = blockIdx.x; }
  __device__ __forceinline__ bool next(int i, Unit& u) const {
    const int L = i * G + c;
    if (L >= nwg) return false;
    const int q = nwg >> 3, xcd = L & 7, off = L >> 3;
    const int wgid = xcd * q + off;
    const int nig = 8 * nN, gid = wgid / nig, fm = gid * 8;
    u.pm = fm + ((wgid % nig) & 7); u.pn = (wgid % nig) >> 3; return true;
  }
};


__device__ __forceinline__ float row_rs(const float* rss, const int row, const int fq) {
  const f32x4* pr = (const f32x4*)(rss + ((size_t)fq * M_PAD + row) * 8);
  const f32x4 a = pr[0], b = pr[1];
  float sm = (a[0] + a[1]) + (a[2] + a[3]) + (b[0] + b[1]) + (b[2] + b[3]);
  sm += __shfl_xor(sm, 16); sm += __shfl_xor(sm, 32);
  return rsqrtf(sm * (1.f / DM) + EPS);
}

template <int EPI, bool WH = true>
__device__ __forceinline__ float epi_quad(const EpiArgs& ea, const int row, const int cb, f32x4 a0, f32x4 a1, const float rs) {
  float ss = 0.f;
  if constexpr (EPI == EPI_GU) {
    const int ac = ((cb & ~31) >> 1) + (cb & 31);
    float v[4];
#pragma unroll
    for (int j = 0; j < 4; ++j) { float g = a0[j] * rs; v[j] = g * sigmoidf_(g) * (a1[j] * rs); }
    uint2 o; o.x = pk2(v[0], v[1]); o.y = pk2(v[2], v[3]);
    *(uint2*)(ea.b0 + (size_t)row * DFF + ac) = o;
  } else if constexpr (EPI == EPI_RES) {
    const float* rp = row < P_ROWS ? ea.xp + (size_t)row * DM : ea.xs + (size_t)(row - P_ROWS) * DM;
    float* wp = ea.xout + (size_t)row * DM;
    f32x4 r0 = *(const f32x4*)(rp + cb), r1 = *(const f32x4*)(rp + cb + 16);
    r0 += ea.scale * a0; r1 += ea.scale * a1;
    *(f32x4*)(wp + cb) = r0; *(f32x4*)(wp + cb + 16) = r1;
    if constexpr (!WH) return 0.f;
    const f32x4 g0 = *(const f32x4*)(ea.gain_out + cb), g1 = *(const f32x4*)(ea.gain_out + cb + 16);
    uint2 o0, o1; o0.x = pk2(r0[0] * g0[0], r0[1] * g0[1]); o0.y = pk2(r0[2] * g0[2], r0[3] * g0[3]);
    o1.x = pk2(r1[0] * g1[0], r1[1] * g1[1]); o1.y = pk2(r1[2] * g1[2], r1[3] * g1[3]);
    *(uint2*)(ea.hout + (size_t)row * DM + cb) = o0; *(uint2*)(ea.hout + (size_t)row * DM + cb + 16) = o1;
#pragma unroll
    for (int j = 0; j < 4; ++j) ss += r0[j] * r0[j] + r1[j] * r1[j];
  } else if constexpr (EPI == EPI_QKVU) {
    a0 *= rs; a1 *= rs;
    const int seg = cb >> 9;
    const int cc = cb & 511;
    u16* dst = ea.b0 + (size_t)seg * ((size_t)M_PAD * DH);
    uint2 o0, o1; o0.x = pk2(a0[0], a0[1]); o0.y = pk2(a0[2], a0[3]); o1.x = pk2(a1[0], a1[1]); o1.y = pk2(a1[2], a1[3]);
    *(uint2*)(dst + (size_t)row * DH + cc) = o0;
    *(uint2*)(dst + (size_t)row * DH + cc + 16) = o1;
    if (seg == 1 || seg == 2) {
      size_t base; bool wrt = true;
      if (row < P_ROWS) {
        const int b = row >> 12, sq = row & 4095;
        wrt = sq >= 2048;
        base = (seg == 1 ? O_KP : O_VP) + ((size_t)(ea.layer * 8 + b) * 2048 + (sq - 2048)) * DH;
      } else {
        const int rs_ = row - P_ROWS; const int b = rs_ >> 2, t = rs_ & 3;
        base = (seg == 1 ? O_KS : O_VS) + ((size_t)(ea.layer * 32 + b) * 2048 + 2044 + t) * DH;
      }
      if (wrt) { __builtin_nontemporal_store(a0, (f32x4*)(ea.out + base + cc)); __builtin_nontemporal_store(a1, (f32x4*)(ea.out + base + cc + 16)); }
    }
  } else if constexpr (EPI == EPI_GLU) {
    const uint2 z0 = *(const uint2*)(ea.zin + (size_t)row * DH + cb), z1 = *(const uint2*)(ea.zin + (size_t)row * DH + cb + 16);
    const f32x4 b0 = *(const f32x4*)(ea.aux + cb), b1 = *(const f32x4*)(ea.aux + cb + 16);
    f32x4 o0, o1;
    o0[0] = bf2f((u16)(z0.x & 0xffff)) * sigmoidf_(a0[0] + b0[0]); o0[1] = bf2f((u16)(z0.x >> 16)) * sigmoidf_(a0[1] + b0[1]);
    o0[2] = bf2f((u16)(z0.y & 0xffff)) * sigmoidf_(a0[2] + b0[2]); o0[3] = bf2f((u16)(z0.y >> 16)) * sigmoidf_(a0[3] + b0[3]);
    o1[0] = bf2f((u16)(z1.x & 0xffff)) * sigmoidf_(a1[0] + b1[0]); o1[1] = bf2f((u16)(z1.x >> 16)) * sigmoidf_(a1[1] + b1[1]);
    o1[2] = bf2f((u16)(z1.y & 0xffff)) * sigmoidf_(a1[2] + b1[2]); o1[3] = bf2f((u16)(z1.y >> 16)) * sigmoidf_(a1[3] + b1[3]);
    *(f32x4*)(ea.fout + (size_t)row * DH + cb) = o0;
    *(f32x4*)(ea.fout + (size_t)row * DH + cb + 16) = o1;
  } else if constexpr (EPI == EPI_PROJ) {
    *(f32x4*)(ea.fout + (size_t)row * DM + cb) = a0;
    *(f32x4*)(ea.fout + (size_t)row * DM + cb + 16) = a1;
  } else if constexpr (EPI == EPI_PLE) {
    float* wp = ea.xout + (size_t)row * DM;
    const float* pp = ea.fin + (size_t)row * DM;
    f32x4 x0 = *(const f32x4*)(wp + cb), x1 = *(const f32x4*)(wp + cb + 16);
    const f32x4 p0 = *(const f32x4*)(pp + cb), p1 = *(const f32x4*)(pp + cb + 16);
#pragma unroll
    for (int j = 0; j < 4; ++j) { x0[j] += sigmoidf_(a0[j] * rs) * p0[j]; x1[j] += sigmoidf_(a1[j] * rs) * p1[j]; }
    *(f32x4*)(wp + cb) = x0; *(f32x4*)(wp + cb + 16) = x1;
    if (WH && ea.gain_out) {
      const f32x4 g0 = *(const f32x4*)(ea.gain_out + cb), g1 = *(const f32x4*)(ea.gain_out + cb + 16);
      uint2 o0, o1; o0.x = pk2(x0[0] * g0[0], x0[1] * g0[1]); o0.y = pk2(x0[2] * g0[2], x0[3] * g0[3]);
      o1.x = pk2(x1[0] * g1[0], x1[1] * g1[1]); o1.y = pk2(x1[2] * g1[2], x1[3] * g1[3]);
      *(uint2*)(ea.hout + (size_t)row * DM + cb) = o0; *(uint2*)(ea.hout + (size_t)row * DM + cb + 16) = o1;
#pragma unroll
      for (int j = 0; j < 4; ++j) ss += x0[j] * x0[j] + x1[j] * x1[j];
    }
  }
  return ss;
}

template <int EPI>
__device__ __forceinline__ void epilogue(const EpiArgs& ea, const f32x4 (&acc)[2][2][4][2], const Unit& u, int wr, int wc, int fr, int fq) {
  const int row0 = u.pm * BM + wr * 64 + fr;
  const int cb0 = u.pn * BM + wc * 32 + 4 * fq;
  if constexpr (EPI == EPI_RES || EPI == EPI_PLE) {
    const bool wh = (EPI == EPI_RES) || (ea.gain_out != nullptr);
    constexpr int RB = (EPI == EPI_RES) ? 2 : 1;
#pragma unroll
    for (int ai = 0; ai < 2; ++ai) {
#pragma unroll
      for (int mp = 0; mp < 4 / RB; ++mp) {
        f32x4 X[RB][2][2], PJ[RB][2][2], gn[2][2]; float rsv[RB];
#pragma unroll
        for (int mm = 0; mm < RB; ++mm) {
          const int row = row0 + ai * HALF + (RB * mp + mm) * 16;
          const float* rp = (EPI == EPI_RES) ? ea.xp + (size_t)row * DM : ea.xout + (size_t)row * DM;
#pragma unroll
          for (int bj = 0; bj < 2; ++bj)
#pragma unroll
            for (int n = 0; n < 2; ++n) {
              X[mm][bj][n] = __builtin_nontemporal_load((const f32x4*)(rp + cb0 + bj * HALF + 16 * n));
              if constexpr (EPI == EPI_PLE) PJ[mm][bj][n] = *(const f32x4*)(ea.fin + (size_t)row * DM + cb0 + bj * HALF + 16 * n);
            }
          if constexpr (EPI == EPI_PLE) rsv[mm] = row_rs(ea.rss_in, row, fq);
        }
#pragma unroll
        for (int bj = 0; bj < 2; ++bj)
#pragma unroll
          for (int n = 0; n < 2; ++n) gn[bj][n] = wh ? *(const f32x4*)(ea.gain_out + cb0 + bj * HALF + 16 * n) : (f32x4){0.f, 0.f, 0.f, 0.f};
#pragma unroll
        for (int mm = 0; mm < RB; ++mm) {
          const int m = RB * mp + mm;
          const int row = row0 + ai * HALF + m * 16;
          float* wp = ea.xout + (size_t)row * DM;
#pragma unroll
          for (int bj = 0; bj < 2; ++bj) {
            const int cb = cb0 + bj * HALF;
            f32x4 r0 = X[mm][bj][0], r1 = X[mm][bj][1];
            const f32x4 a0 = acc[ai][bj][m][0], a1 = acc[ai][bj][m][1];
            if constexpr (EPI == EPI_RES) { r0 += ea.scale * a0; r1 += ea.scale * a1; }
            else {
#pragma unroll
              for (int j = 0; j < 4; ++j) { r0[j] += sigmoidf_(a0[j] * rsv[mm]) * PJ[mm][bj][0][j]; r1[j] += sigmoidf_(a1[j] * rsv[mm]) * PJ[mm][bj][1][j]; }
            }
            __builtin_nontemporal_store(r0, (f32x4*)(wp + cb)); __builtin_nontemporal_store(r1, (f32x4*)(wp + cb + 16));
            if (wh) {
              uint2 o0, o1;
              o0.x = pk2(r0[0] * gn[bj][0][0], r0[1] * gn[bj][0][1]); o0.y = pk2(r0[2] * gn[bj][0][2], r0[3] * gn[bj][0][3]);
              o1.x = pk2(r1[0] * gn[bj][1][0], r1[1] * gn[bj][1][1]); o1.y = pk2(r1[2] * gn[bj][1][2], r1[3] * gn[bj][1][3]);
              *(uint2*)(ea.hout + (size_t)row * DM + cb) = o0; *(uint2*)(ea.hout + (size_t)row * DM + cb + 16) = o1;
              float ss = 0.f;
#pragma unroll
              for (int j = 0; j < 4; ++j) ss += r0[j] * r0[j] + r1[j] * r1[j];
              ss += __shfl_xor(ss, 16); ss += __shfl_xor(ss, 32);
              if (fq == 0) ea.rss_out[((size_t)u.pn * M_PAD + row) * 8 + bj * 4 + wc] = ss;
            }
          }
        }
      }
    }
  } else {
    float rsv[2][4];
#pragma unroll
    for (int ai = 0; ai < 2; ++ai)
#pragma unroll
      for (int m = 0; m < 4; ++m) {
        rsv[ai][m] = 1.f;
        if constexpr (EPI == EPI_GU || EPI == EPI_QKVU) rsv[ai][m] = row_rs(ea.rss_in, row0 + ai * HALF + m * 16, fq);
      }
#pragma unroll
    for (int ai = 0; ai < 2; ++ai) {
#pragma unroll
      for (int m = 0; m < 4; ++m) {
        const int row = row0 + ai * HALF + m * 16;
#pragma unroll
        for (int bj = 0; bj < 2; ++bj)
          (void)epi_quad<EPI>(ea, row, cb0 + bj * HALF, acc[ai][bj][m][0], acc[ai][bj][m][1], rsv[ai][m]);
      }
    }
  }
}

template <int EPI>
__device__ __forceinline__ void gemm_phase(const u16* gA, const u16* gBt, const int K, const int N, const EpiArgs& ea) {
  extern __shared__ __attribute__((aligned(16))) unsigned char smem[];
  LAS unsigned char* lds = (LAS unsigned char*)smem;
  IDS();
  Sched S; S.nN = N >> 8; S.nwg = 128 * S.nN; S.G = GDIM; S.c = BID;
  const int tid = TID, wid = __builtin_amdgcn_readfirstlane(tid >> 6), lane = tid & 63, wr = wid >> 2, wc = wid & 3, fr = lane & 15, fq = lane >> 4;
  const int nt = K / BK;
  for (int cg = BID; cg < (N >> 5); cg += GDIM) {
    const int c0 = cg * 32; const int row = P_ROWS + 16 * wid + fr;
    f32x4 c0a = {0.f, 0.f, 0.f, 0.f}, c1a = {0.f, 0.f, 0.f, 0.f};
    const u16* ap = gA + (size_t)row * K + 8 * fq; const u16* bp0 = gBt + (size_t)(c0 + fr) * K + 8 * fq; const u16* bp1 = bp0 + (size_t)16 * K;
    const int nks = K >> 5;
    int k0 = 0;
#define SK_CHUNK(C) { bf16x8 av[C], b0v[C], b1v[C]; \
      _Pragma("unroll") for (int u = 0; u < C; ++u) { av[u] = *(const bf16x8*)(ap + 32 * (k0 + u)); b0v[u] = *(const bf16x8*)(bp0 + 32 * (k0 + u)); b1v[u] = *(const bf16x8*)(bp1 + 32 * (k0 + u)); } \
      _Pragma("unroll") for (int u = 0; u < C; ++u) { c0a = __builtin_amdgcn_mfma_f32_16x16x32_bf16(b0v[u], av[u], c0a, 0, 0, 0); c1a = __builtin_amdgcn_mfma_f32_16x16x32_bf16(b1v[u], av[u], c1a, 0, 0, 0); } }
    for (; k0 + 16 <= nks; k0 += 16) SK_CHUNK(16)
    for (; k0 < nks; k0 += 8) SK_CHUNK(8)
#undef SK_CHUNK
    float rs = 1.f;
    if constexpr (EPI == EPI_GU || EPI == EPI_QKVU || EPI == EPI_PLE) rs = row_rs(ea.rss_in, row, fq);
    (void)epi_quad<EPI, false>(ea, row, c0 + 4 * fq, c0a, c1a, rs);
  }
  unsigned voffA[2];
#pragma unroll
  for (int i = 0; i < 2; ++i) { int R, C; stage_rc(tid * 16 + i * 8192, R, C); voffA[i] = (unsigned)(R * K + C) * 2u; }
  const size_t kstep = (size_t)(BK * 2);
  const size_t hstep = (size_t)HALF * K * 2;
  const size_t tstep = 2 * hstep;
  const unsigned ldsw = (unsigned)wid * 1024u;
  const int aoff = lds_byte(wr * 64 + fr, fq * 8), boff = lds_byte(wc * 32 + fr, fq * 8);
#define PG8_SA(b, h) (((b) * 2 + (h)) * HTB)
#define PG8_SB(b, h) ((4 + (b) * 2 + (h)) * HTB)
#define PG8_STAGE(bufoff, gbase, voff) do { _Pragma("unroll") for (int _i = 0; _i < 2; ++_i) \
        __builtin_amdgcn_global_load_lds((const unsigned*)((const char*)(gbase) + (voff)[_i]), (LAS unsigned*)(lds + (bufoff) + ldsw + _i * 8192), 16, 0, 0); } while (0)
#define PG8_LDA(dst, b, h) do { _Pragma("unroll") for (int m = 0; m < 4; ++m) _Pragma("unroll") for (int k = 0; k < 2; ++k) dst[m][k] = *(const LAS bf16x8*)(lds + PG8_SA(b, h) + aoff + m * 2048 + k * 1024); } while (0)
#define PG8_LDB(dst, b, h) do { _Pragma("unroll") for (int n = 0; n < 2; ++n) _Pragma("unroll") for (int k = 0; k < 2; ++k) dst[n][k] = *(const LAS bf16x8*)(lds + PG8_SB(b, h) + boff + n * 2048 + k * 1024); } while (0)
#define PG8_MMA(ai, bj, At, Bt) do { __builtin_amdgcn_s_setprio(1); _Pragma("unroll") for (int m = 0; m < 4; ++m) _Pragma("unroll") for (int n = 0; n < 2; ++n) _Pragma("unroll") for (int k = 0; k < 2; ++k) \
        acc[ai][bj][m][n] = __builtin_amdgcn_mfma_f32_16x16x32_bf16(Bt[n][k], At[m][k], acc[ai][bj][m][n], 0, 0, 0); __builtin_amdgcn_s_setprio(0); } while (0)
#define PG8_WAIT_V(n) asm volatile("s_waitcnt vmcnt(" #n ")" ::: "memory")
#define PG8_WAIT_L(n) asm volatile("s_waitcnt lgkmcnt(" #n ")" ::: "memory")
#define PG8_BAR __builtin_amdgcn_s_barrier()
#define PG8_SCHED __builtin_amdgcn_sched_barrier(0)
  Unit cur, nxt; int ui = 0;
  if (S.next(0, cur)) {
    f32x4 acc[2][2][4][2];
#pragma unroll
    for (int a = 0; a < 2; ++a)
#pragma unroll
      for (int b = 0; b < 2; ++b)
#pragma unroll
        for (int m = 0; m < 4; ++m)
#pragma unroll
          for (int n = 0; n < 2; ++n) acc[a][b][m][n] = (f32x4){0.f, 0.f, 0.f, 0.f};
    bf16x8 At[4][2], B0[2][2], B1[2][2];
    const char* cA = (const char*)gA + (size_t)cur.pm * tstep; const char* cB = (const char*)gBt + (size_t)cur.pn * tstep;
    PG8_STAGE(PG8_SB(0, 0), cB, voffA); PG8_STAGE(PG8_SA(0, 0), cA, voffA); PG8_STAGE(PG8_SB(0, 1), cB + hstep, voffA); PG8_STAGE(PG8_SA(0, 1), cA + hstep, voffA);
    if (wr == 1) PG8_BAR;
    PG8_WAIT_V(4); PG8_BAR;
    PG8_STAGE(PG8_SB(1, 0), cB + kstep, voffA); PG8_STAGE(PG8_SA(1, 0), cA + kstep, voffA); PG8_STAGE(PG8_SB(1, 1), cB + hstep + kstep, voffA);
    PG8_WAIT_V(6); PG8_BAR;
    for (;;) {
      const bool has_next = S.next(ui + 1, nxt);
      const char* nA = has_next ? (const char*)gA + (size_t)nxt.pm * tstep : cA; const char* nB = has_next ? (const char*)gBt + (size_t)nxt.pn * tstep : cB;
      for (int t = 0; t < nt; t += 2) {
        const bool last = (t == nt - 2);
        const char* a1 = cA + (size_t)(t + 1) * kstep;
        const char* a2 = last ? nA : cA + (size_t)(t + 2) * kstep; const char* b2 = last ? nB : cB + (size_t)(t + 2) * kstep;
        const char* a3 = a2 + kstep; const char* b3 = b2 + kstep;
        PG8_LDB(B0, 0, 0); PG8_SCHED; PG8_LDA(At, 0, 0); PG8_STAGE(PG8_SA(1, 1), a1 + hstep, voffA);
        PG8_WAIT_L(8); PG8_BAR; PG8_WAIT_L(0); PG8_MMA(0, 0, At, B0); PG8_BAR; PG8_SCHED;
        PG8_LDB(B1, 0, 1); PG8_STAGE(PG8_SB(0, 0), b2, voffA);
        PG8_BAR; PG8_WAIT_L(0); PG8_MMA(0, 1, At, B1); PG8_BAR;
        PG8_LDA(At, 0, 1); PG8_STAGE(PG8_SA(0, 0), a2, voffA);
        PG8_BAR; PG8_WAIT_L(0); PG8_MMA(1, 0, At, B0); PG8_BAR; PG8_SCHED;
        PG8_STAGE(PG8_SB(0, 1), b2 + hstep, voffA);
        PG8_WAIT_V(6); PG8_BAR; PG8_MMA(1, 1, At, B1); PG8_BAR;
        PG8_LDB(B0, 1, 0); PG8_SCHED; PG8_LDA(At, 1, 0); PG8_STAGE(PG8_SA(0, 1), a2 + hstep, voffA);
        PG8_WAIT_L(8); PG8_BAR; PG8_WAIT_L(0); PG8_MMA(0, 0, At, B0); PG8_BAR; PG8_SCHED;
        PG8_LDB(B1, 1, 1); PG8_STAGE(PG8_SB(1, 0), b3, voffA);
        PG8_BAR; PG8_WAIT_L(0); PG8_MMA(0, 1, At, B1); PG8_BAR;
        PG8_LDA(At, 1, 1); PG8_STAGE(PG8_SA(1, 0), a3, voffA);
        PG8_BAR; PG8_WAIT_L(0); PG8_MMA(1, 0, At, B0); PG8_BAR; PG8_SCHED;
        PG8_STAGE(PG8_SB(1, 1), b3 + hstep, voffA);
        PG8_WAIT_V(6); PG8_BAR; PG8_MMA(1, 1, At, B1); PG8_BAR;
      }
      epilogue<EPI>(ea, acc, cur, wr, wc, fr, fq);
      if (!has_next) break;
#pragma unroll
      for (int a = 0; a < 2; ++a)
#pragma unroll
        for (int b = 0; b < 2; ++b)
#pragma unroll
          for (int m = 0; m < 4; ++m)
#pragma unroll
            for (int n = 0; n < 2; ++n) acc[a][b][m][n] = (f32x4){0.f, 0.f, 0.f, 0.f};
      cur = nxt; cA = nA; cB = nB; ++ui;
    }
    PG8_WAIT_V(0);
    if (wr == 0) PG8_BAR;
    PG8_BAR;
  }
  __syncthreads();
#undef PG8_SA
#undef PG8_SB
#undef PG8_STAGE
#undef PG8_LDA
#undef PG8_LDB
#undef PG8_MMA
}

struct CvtJob { const float* sp; u16* dp; };
__device__ __forceinline__ CvtJob cvt_job(const Params& p, u16* W, const int t, const int tid) {
  int layer = t / 5376, r = t % 5376;
  const float* src; u16* dst; int K, N, mode = 0;
  u16* Wl = W + (size_t)layer * LW_SIZE;
  if (r < 4224) {
    int j = r / 2112; int rr = r % 2112; int which = rr / 704; r = rr % 704;
    size_t so = (size_t)(layer * 2 + j) * (size_t)DM * DFF;
    if (which == 0) { src = p.in[15] + so; K = DM; N = DFF; mode = 1; dst = Wl + (j ? LW_GU1 : LW_GU0); }
    else if (which == 1) { src = p.in[16] + so; K = DM; N = DFF; mode = 2; dst = Wl + (j ? LW_GU1 : LW_GU0); }
    else { src = p.in[17] + so; K = DFF; N = DM; dst = Wl + (j ? LW_D1 : LW_D0); }
  } else if (r < 4736) { r -= 4224; src = p.in[9] + (size_t)layer * DM * DIN; K = DM; N = DIN; dst = Wl + LW_IN; }
  else if (r < 4992) { r -= 4736; src = p.in[10] + (size_t)layer * DM * DM; K = DM; N = DM; dst = Wl + LW_OUT; }
  else if (r < 5248) { r -= 4992; src = p.in[29] + (size_t)layer * DM * DM; K = DM; N = DM; dst = Wl + LW_PG; }
  else if (r < 5312) { r -= 5248; src = p.in[30] + (size_t)layer * DPLE * DM; K = DPLE; N = DM; dst = Wl + LW_PP; }
  else { r -= 5312; src = p.in[26] + (size_t)layer * DH * DH; K = DH; N = DH; dst = Wl + LW_GLU; }
  const int ntn = N >> 6; const int kt = r / ntn, nt = r % ntn;
  CvtJob jb;
  { const int kr = tid >> 3, c8 = (tid & 7) * 8; jb.sp = src + (size_t)(kt * 64 + kr) * N + nt * 64 + c8; }
  { const int n = tid >> 3, k0 = (tid & 7) * 8; const int c = nt * 64 + n; int drow = c;
    if (mode == 1) drow = 32 * (c >> 4) + (c & 15); else if (mode == 2) drow = 32 * (c >> 4) + 16 + (c & 15);
    jb.dp = dst + (size_t)drow * K + kt * 64 + k0; }
  return jb;
}
__device__ void convert_weights(const Params& p) {
  IDS(); unsigned char* const WS = launder_p(p.ws);
  extern __shared__ __attribute__((aligned(16))) unsigned char smem[];
  float* tiles = (float*)smem;
  u16* W = (u16*)(WS + WS_W);
  const int tid = TID;
  const int total = 2 * 5376;
  float4 v0 = make_float4(0.f, 0.f, 0.f, 0.f), v1 = v0; u16* dcur = nullptr;
  if (BID < total) { const CvtJob jb = cvt_job(p, W, BID, tid); v0 = ((const float4*)jb.sp)[0]; v1 = ((const float4*)jb.sp)[1]; dcur = jb.dp; }
  int buf = 0;
  for (int t = BID; t < total; t += GDIM) {
    float* tile = tiles + buf * (64 * 65);
    {
      const int kr = tid >> 3, c8 = (tid & 7) * 8;
      float* tp = tile + kr * 65 + c8;
      tp[0] = v0.x; tp[1] = v0.y; tp[2] = v0.z; tp[3] = v0.w; tp[4] = v1.x; tp[5] = v1.y; tp[6] = v1.z; tp[7] = v1.w;
    }
    __syncthreads();
    u16* const dnow = dcur;
    if (t + GDIM < total) { const CvtJob jb = cvt_job(p, W, t + GDIM, tid); v0 = ((const float4*)jb.sp)[0]; v1 = ((const float4*)jb.sp)[1]; dcur = jb.dp; }
    {
      const int n = tid >> 3, k0 = (tid & 7) * 8;
      uint4 o;
      o.x = pk2(tile[(k0 + 0) * 65 + n], tile[(k0 + 1) * 65 + n]); o.y = pk2(tile[(k0 + 2) * 65 + n], tile[(k0 + 3) * 65 + n]);
      o.z = pk2(tile[(k0 + 4) * 65 + n], tile[(k0 + 5) * 65 + n]); o.w = pk2(tile[(k0 + 6) * 65 + n], tile[(k0 + 7) * 65 + n]);
      *(uint4*)dnow = o;
    }
    buf ^= 1;
  }
  __syncthreads();
}

__device__ void make_tables(const Params& p) {
  IDS(); unsigned char* const WS = launder_p(p.ws);
  int gt = BID * 512 + TID;
  if (gt < 4096) {
    int layer = gt >> 11, g = (gt >> 6) & 31, n = gt & 63;
    int gi = layer * 32 + g;
    double dt = exp((double)p.in[20][gi]);
    double are = p.in[18][gi * 64 + n], aim = p.in[19][gi * 64 + n];
    double mag = exp(are * dt), ar = mag * cos(aim * dt), ai = mag * sin(aim * dt);
    float* abar = (float*)(WS + WS_ABAR); float* abart = (float*)(WS + WS_ABART);
    abar[(gi * 64 + n) * 2] = (float)ar; abar[(gi * 64 + n) * 2 + 1] = (float)ai;
    double pr = ar, pi = ai;
    for (int s = 0; s < 7; ++s) { double nr = pr * pr - pi * pi, ni = 2 * pr * pi; pr = nr; pi = ni; }
    abart[(gi * 64 + n) * 2] = (float)pr; abart[(gi * 64 + n) * 2 + 1] = (float)pi;
    double nr_ = ar - 1.0, ni_ = ai; double den = are * are + aim * aim;
    double cr = (nr_ * are + ni_ * aim) / den, ci = (ni_ * are - nr_ * aim) / den;
    u16* bmt = (u16*)(WS + WS_BMT); u16* cmt = (u16*)(WS + WS_CMT);
    for (int i = 0; i < 16; ++i) {
      double br = p.in[21][(gi * 64 + n) * 16 + i], bi = p.in[22][(gi * 64 + n) * 16 + i];
      bmt[((size_t)gi * 128 + n) * 16 + i] = f2bf((float)(cr * br - ci * bi));
      bmt[((size_t)gi * 128 + 64 + n) * 16 + i] = f2bf((float)(cr * bi + ci * br));
    }
    for (int o = 0; o < 16; ++o) {
      cmt[((size_t)gi * 16 + o) * 128 + n] = f2bf(p.in[23][(gi * 16 + o) * 64 + n]);
      cmt[((size_t)gi * 16 + o) * 128 + 64 + n] = f2bf(-p.in[24][(gi * 16 + o) * 64 + n]);
    }
  }
  if (gt >= 4096 && gt < 4096 + 3 * 129) {
    int q = gt - 4096; int g = q / 129, j = q % 129; int d = g == 0 ? 1 : (g == 1 ? 4 : 16);
    int dist = j * d; int bk;
    if (dist < 16) bk = dist;
    else { bk = 16 + (int)(log((double)dist / 16.0) / log(128.0) * 16.0); if (bk > 31) bk = 31; }
    float* bias = (float*)(WS + WS_BIAS);
    for (int h = 0; h < 8; ++h) bias[(g * 8 + h) * 132 + j] = p.in[8][bk * 8 + h];
  }
}

__device__ void copy_cache(const Params& p) {
  IDS();
  const size_t per = 2044 * 512 / 4;
  const size_t total = per * 64 * 2;
  const size_t stride = (size_t)GDIM * 512;
  for (size_t i0 = (size_t)BID * 512 + TID; i0 < total; i0 += 4 * stride) {
    f32x4 v[4];
#pragma unroll
    for (int q = 0; q < 4; ++q) {
      size_t i = i0 + q * stride;
      if (i < total) {
        size_t seg = i / per, off = i % per; int kv = (int)(seg >> 6); size_t sb = seg & 63;
        v[q] = __builtin_nontemporal_load((const f32x4*)(p.in[4 + kv] + sb * (2048 * 512) + 4 * 512) + off);
      }
    }
#pragma unroll
    for (int q = 0; q < 4; ++q) {
      size_t i = i0 + q * stride;
      if (i < total) {
        size_t seg = i / per, off = i % per; int kv = (int)(seg >> 6); size_t sb = seg & 63;
        __builtin_nontemporal_store(v[q], (f32x4*)(p.out + (kv ? O_VS : O_KS) + sb * (2048 * 512)) + off);
      }
    }
  }
}

__device__ void prenorm_phase(const float* xp, const float* xs, const float* gain, u16* dst, float* rss, const int row_lo = 0) {
  IDS();
  const int lane = TID & 63; const int gw = BID * 8 + (TID >> 6); const int nw = GDIM * 8;
  float4 g[4];
  for (int i = 0; i < 4; ++i) g[i] = ((const float4*)gain)[i * 64 + lane];
  for (int row = row_lo + gw; row < M_ROWS; row += nw) {
    const float4* rp = (const float4*)(row < P_ROWS ? xp + (size_t)row * DM : xs + (size_t)(row - P_ROWS) * DM);
    float4 v[4]; float ss = 0.f;
    for (int i = 0; i < 4; ++i) { v[i] = rp[i * 64 + lane]; ss += v[i].x * v[i].x + v[i].y * v[i].y + v[i].z * v[i].z + v[i].w * v[i].w; }
    ss = wave_sum(ss);
    if (lane < 32) rss[((size_t)(lane >> 3) * M_PAD + row) * 8 + (lane & 7)] = lane == 0 ? ss : 0.f;
    for (int i = 0; i < 4; ++i) {
      uint2 o;
      o.x = pk2(v[i].x * g[i].x, v[i].y * g[i].y);
      o.y = pk2(v[i].z * g[i].z, v[i].w * g[i].w);
      *(uint2*)(dst + (size_t)row * DM + (i * 64 + lane) * 4) = o;
    }
  }
}

__device__ void final_norm_phase(const Params& p) {
  IDS(); unsigned char* const WS = launder_p(p.ws);
  const float* x = (const float*)(WS + WS_X); const float* gain = p.in[31];
  const int lane = TID & 63; const int gw = BID * 8 + (TID >> 6); const int nw = GDIM * 8;
  float4 g[4];
  for (int i = 0; i < 4; ++i) g[i] = ((const float4*)gain)[i * 64 + lane];
  for (int row = gw; row < M_ROWS; row += nw) {
    const float4* rp = (const float4*)(x + (size_t)row * DM);
    float4 v[4]; float ss = 0.f;
    for (int i = 0; i < 4; ++i) { v[i] = rp[i * 64 + lane]; ss += v[i].x * v[i].x + v[i].y * v[i].y + v[i].z * v[i].z + v[i].w * v[i].w; }
    ss = wave_sum(ss);
    float rs = rsqrtf(ss * (1.f / DM) + EPS);
    float4* op = (float4*)(p.out + (row < P_ROWS ? O_YP + (size_t)row * DM : O_YS + (size_t)(row - P_ROWS) * DM));
    for (int i = 0; i < 4; ++i) {
      float4 o; o.x = v[i].x * rs * g[i].x; o.y = v[i].y * rs * g[i].y; o.z = v[i].z * rs * g[i].z; o.w = v[i].w * rs * g[i].w;
      op[i * 64 + lane] = o;
    }
  }
}

__device__ void pconv_phase(const Params& p, int layer) {
  IDS(); unsigned char* const WS = launder_p(p.ws);
  u16* pbf = (u16*)(WS + WS_PBF);
  const size_t total = (size_t)M_ROWS * DPLE / 4;
  const float* pp = p.in[2] + (size_t)layer * P_ROWS * DPLE;
  const float* ps = p.in[3] + (size_t)layer * S_ROWS * DPLE;
  for (size_t i = (size_t)BID * 512 + TID; i < total; i += (size_t)GDIM * 512) {
    size_t e = i * 4;
    float4 v = e < (size_t)P_ROWS * DPLE ? *(const float4*)(pp + e) : *(const float4*)(ps + (e - (size_t)P_ROWS * DPLE));
    uint2 o; o.x = pk2(v.x, v.y); o.y = pk2(v.z, v.w);
    *(uint2*)(pbf + e) = o;
  }
}

__device__ void attn_prompt_phase(const Params& p, int layer) {
  IDS(); unsigned char* const WS = launder_p(p.ws);
  extern __shared__ __attribute__((aligned(16))) unsigned char smem[];
  u16* Ks = (u16*)smem;
  u16* Vt = Ks + 256 * 72;
  const u16* qb = (const u16*)(WS + WS_Q); const u16* kb = (const u16*)(WS + WS_K); const u16* vb = (const u16*)(WS + WS_V);
  u16* ob = (u16*)(WS + WS_O); float* lseb = (float*)(WS + WS_LSE);
  const float* biasT = (const float*)(WS + WS_BIAS);
  const int tid = TID, w = tid >> 6, lane = tid & 63, fr = lane & 15, fq = lane >> 4;
  int cached_gh = -1; float bv[9][4];
  const bool bal = (GDIM == 256);
  const int njobs = bal ? (BID < 128 ? 19 : 29) : (6144 - BID + GDIM - 1) / GDIM;
  for (int jj = 0; jj < njobs; ++jj) {
    const int item = (bal && jj >= 24) ? (BID - 128) + 256 * (jj - 5) : BID + GDIM * jj;
    int h = item & 7; int t = item >> 3;
    int g = t >> 8; int u = t & 255;
    int d = (g == 0) ? 1 : (g == 1 ? 4 : 16);
    int nqb = 32 / d;
    int qblk = u % nqb; int br = u / nqb; int r = br % d; int b = br / d;
    int i0 = qblk * 128;
    {
      const int kg = tid >> 3, ch = tid & 7;
      uint4 kq[4], vq[4];
#pragma unroll
      for (int it = 0; it < 4; ++it) {
        const int kr = 4 * kg + it; const int ip = i0 - 128 + kr;
        kq[it] = make_uint4(0, 0, 0, 0); vq[it] = make_uint4(0, 0, 0, 0);
        if (ip >= 0) {
          const size_t row = (size_t)b * SEQ + r + d * ip;
          kq[it] = *(const uint4*)(kb + row * DH + h * 64 + ch * 8);
          vq[it] = *(const uint4*)(vb + row * DH + h * 64 + ch * 8);
        }
      }
#pragma unroll
      for (int it = 0; it < 4; ++it) *(uint4*)(Ks + (4 * kg + it) * 72 + ch * 8) = kq[it];
      const int pcol = (4 * kg) ^ ((ch & 1) << 5);
      const unsigned vw[4][4] = {{vq[0].x, vq[0].y, vq[0].z, vq[0].w}, {vq[1].x, vq[1].y, vq[1].z, vq[1].w},
                                 {vq[2].x, vq[2].y, vq[2].z, vq[2].w}, {vq[3].x, vq[3].y, vq[3].z, vq[3].w}};
#pragma unroll
      for (int j2 = 0; j2 < 4; ++j2) {
        uint2 ev, od;
        ev.x = (vw[0][j2] & 0xffffu) | (vw[1][j2] << 16); ev.y = (vw[2][j2] & 0xffffu) | (vw[3][j2] << 16);
        od.x = (vw[0][j2] >> 16) | (vw[1][j2] & 0xffff0000u); od.y = (vw[2][j2] >> 16) | (vw[3][j2] & 0xffff0000u);
        *(uint2*)(Vt + (ch * 8 + 2 * j2) * 264 + pcol) = ev;
        *(uint2*)(Vt + (ch * 8 + 2 * j2 + 1) * 264 + pcol) = od;
      }
    }
    __syncthreads();
    int iq = i0 + 16 * w + fr; size_t qrow = (size_t)b * SEQ + r + d * iq;
    bf16x8 qf[2];
    for (int kk = 0; kk < 2; ++kk) qf[kk] = *(const bf16x8*)(qb + qrow * DH + h * 64 + kk * 32 + fq * 8);
    f32x4 s[9];
    for (int kt = 0; kt < 9; ++kt) {
      s[kt] = (f32x4){0.f, 0.f, 0.f, 0.f};
      for (int kk = 0; kk < 2; ++kk) {
        bf16x8 a = *(const bf16x8*)(Ks + (16 * w + 16 * kt + fr) * 72 + kk * 32 + fq * 8);
        s[kt] = __builtin_amdgcn_mfma_f32_16x16x32_bf16(a, qf[kk], s[kt], 0, 0, 0);
      }
    }
    if (g * 8 + h != cached_gh) {
      cached_gh = g * 8 + h;
      const float* bT = biasT + (g * 8 + h) * 132;
#pragma unroll
      for (int kt = 0; kt < 9; ++kt)
#pragma unroll
        for (int v = 0; v < 4; ++v) {
          const int step = 128 + fr - 16 * kt - 4 * fq - v;
          const int sc = step < 0 ? 0 : (step > 128 ? 128 : step);
          const float bb = bT[sc] * 1.4426950408889634f;
          bv[kt][v] = (step >= 0 && step <= 128) ? bb : -1e30f;
        }
    }
    float mx = -3e38f;
    if (i0 == 0) {
#pragma unroll
      for (int kt = 0; kt < 9; ++kt)
#pragma unroll
        for (int v = 0; v < 4; ++v) {
          const int ip = 16 * w - 128 + 16 * kt + 4 * fq + v;
          const float lg = (ip >= 0) ? s[kt][v] * (0.125f * 1.4426950408889634f) + bv[kt][v] : -1e30f;
          s[kt][v] = lg; mx = fmaxf(mx, lg);
        }
    } else {
#pragma unroll
      for (int kt = 0; kt < 9; ++kt)
#pragma unroll
        for (int v = 0; v < 4; ++v) { const float lg = s[kt][v] * (0.125f * 1.4426950408889634f) + bv[kt][v]; s[kt][v] = lg; mx = fmaxf(mx, lg); }
    }
    mx = fmaxf(mx, __shfl_xor(mx, 16)); mx = fmaxf(mx, __shfl_xor(mx, 32));
    float sum = 0.f;
    for (int kt = 0; kt < 9; ++kt) for (int v = 0; v < 4; ++v) { float e = __builtin_amdgcn_exp2f(s[kt][v] - mx); s[kt][v] = e; sum += e; }
    sum += __shfl_xor(sum, 16); sum += __shfl_xor(sum, 32);
    f32x4 o[4];
    for (int mt = 0; mt < 4; ++mt) o[mt] = (f32x4){0.f, 0.f, 0.f, 0.f};
    for (int ks = 0; ks < 5; ++ks) {
      union { uint4 u; bf16x8 v; } pu;
      pu.u.x = pk2(s[2 * ks][0], s[2 * ks][1]); pu.u.y = pk2(s[2 * ks][2], s[2 * ks][3]);
      if (ks < 4) { pu.u.z = pk2(s[2 * ks + 1][0], s[2 * ks + 1][1]); pu.u.w = pk2(s[2 * ks + 1][2], s[2 * ks + 1][3]); }
      else { pu.u.z = 0u; pu.u.w = 0u; }
      const bf16x8 pf = pu.v;
      for (int mt = 0; mt < 4; ++mt) {
        const int swz = ((fr >> 3) & 1) << 5;
        const u16* vrow = Vt + (16 * mt + fr) * 264;
        uint2 lo = *(const uint2*)(vrow + ((16 * w + 32 * ks + 4 * fq) ^ swz));
        uint2 hi = make_uint2(0, 0);
        if (ks < 4) hi = *(const uint2*)(vrow + ((16 * w + 32 * ks + 16 + 4 * fq) ^ swz));
        union { uint4 u; bf16x8 v; } cv; cv.u = make_uint4(lo.x, lo.y, hi.x, hi.y);
        o[mt] = __builtin_amdgcn_mfma_f32_16x16x32_bf16(cv.v, pf, o[mt], 0, 0, 0);
      }
    }
    float inv = 1.f / sum;
    u16* op = ob + ((size_t)g * M_PAD + qrow) * DH + h * 64;
    for (int mt = 0; mt < 4; ++mt) {
      uint2 ov;
      ov.x = pk2(o[mt][0] * inv, o[mt][1] * inv);
      ov.y = pk2(o[mt][2] * inv, o[mt][3] * inv);
      *(uint2*)(op + 16 * mt + 4 * fq) = ov;
    }
    if (fq == 0) lseb[(size_t)((g * 8 + h) * 8 + b) * SEQ + r * (SEQ / d) + iq] = (mx + __log2f(sum)) * 0.6931471805599453f;
    __syncthreads();
  }
}

__device__ void attn_sample_phase(const Params& p, int layer) {
  IDS(); unsigned char* const WS = launder_p(p.ws);
  extern __shared__ __attribute__((aligned(16))) unsigned char smem[];
  const int tid = TID, w = tid >> 6, lane = tid & 63;
  float* pl = (float*)smem + w * 1024;
  int* el = (int*)(pl + 448);
  float* ql = pl + 896;
  const u16* qb = (const u16*)(WS + WS_Q);
  u16* ob = (u16*)(WS + WS_O); float* lseb = (float*)(WS + WS_LSE);
  const float* biasT = (const float*)(WS + WS_BIAS);
  for (int item = BID * 8 + w; item < 1024; item += GDIM * 8) {
    int h = item & 7, t = (item >> 3) & 3, b = item >> 5;
    int row = P_ROWS + b * 4 + t;
    ql[lane] = bf2f(qb[(size_t)row * DH + h * 64 + lane]);
    LDS_FENCE();
    const float* ck = p.in[4] + (size_t)(layer * 32 + b) * 2048 * 512 + h * 64;
    const float* cv = p.in[5] + (size_t)(layer * 32 + b) * 2048 * 512 + h * 64;
    const float* nk = p.out + O_KS + ((size_t)(layer * 32 + b) * 2048 + 2044) * 512 + h * 64;
    const float* nv = p.out + O_VS + ((size_t)(layer * 32 + b) * 2048 + 2044) * 512 + h * 64;
    float mx = -3e38f;
#pragma unroll 2
    for (int i = 0; i < 7; ++i) {
      int s = lane + 64 * i; float l = -1e30f; int e = 0;
      if (s < 387) {
        int g = s / 129, j = s - 129 * g; int d = g == 0 ? 1 : (g == 1 ? 4 : 16);
        e = 2048 + t - j * d;
        const float4* kr = (const float4*)(e >= 2048 ? nk + (size_t)(e - 2048) * 512 : ck + (size_t)e * 512);
        float dot = 0.f;
#pragma unroll
        for (int c = 0; c < 16; ++c) { float4 kv = kr[c]; float4 qv = ((const float4*)ql)[c]; dot += kv.x * qv.x + kv.y * qv.y + kv.z * qv.z + kv.w * qv.w; }
        l = dot * 0.125f + biasT[(g * 8 + h) * 132 + j];
      }
      mx = fmaxf(mx, l); pl[s] = l; el[s] = e;
    }
    mx = wave_max(mx);
    float sum = 0.f;
#pragma unroll
    for (int i = 0; i < 7; ++i) { float ev = __expf(pl[lane + 64 * i] - mx); pl[lane + 64 * i] = ev; sum += ev; }
    sum = wave_sum(sum);
    const float inv = 1.f / sum;
    LDS_FENCE();
    const int sg = lane >> 4, d4 = lane & 15;
    f32x4 acc = {0.f, 0.f, 0.f, 0.f};
#pragma unroll 8
    for (int it = 0; it < 97; ++it) {
      const int s = 4 * it + sg;
      const float pw = pl[s]; const int e = el[s];
      const float* vr = e >= 2048 ? nv + (size_t)(e - 2048) * 512 : cv + (size_t)e * 512;
      const f32x4 vv = *(const f32x4*)(vr + 4 * d4);
      acc += pw * vv;
    }
#pragma unroll
    for (int j = 0; j < 4; ++j) { acc[j] += __shfl_xor(acc[j], 16); acc[j] += __shfl_xor(acc[j], 32); }
    LDS_FENCE();
    if (sg == 0) {
      uint2 o; o.x = pk2(acc[0] * inv, acc[1] * inv); o.y = pk2(acc[2] * inv, acc[3] * inv);
      *(uint2*)(ob + ((size_t)0 * M_PAD + row) * DH + h * 64 + 4 * d4) = o;
    }
  }
}

template <int MODE>
__device__ void s5_phase(const Params& p, int layer) {
  IDS(); unsigned char* const WS = launder_p(p.ws);
  extern __shared__ __attribute__((aligned(16))) unsigned char smem[];
  const int tid = TID, w = tid >> 6, lane = tid & 63, fr = lane & 15, fq = lane >> 4;
  float* bu = (float*)(smem + w * 12800);
  u16* hb = (u16*)(smem + w * 12800 + 8448);
  const u16* ub = (const u16*)(WS + WS_U);
  float* yl = (float*)(WS + WS_YL); u16* zb = (u16*)(WS + WS_Z); float* Eb = (float*)(WS + WS_E);
  const float* abar = (const float*)(WS + WS_ABAR); const float* abart = (const float*)(WS + WS_ABART);
  const u16* bmt = (const u16*)(WS + WS_BMT); const u16* cmt = (const u16*)(WS + WS_CMT);
  const float* dsk = p.in[25] + layer * DH;
  const int nitems = (MODE == 1) ? 1024 : 8192;
  for (int item = BID * 8 + w; item < nitems; item += GDIM * 8) {
    int g, row0, T, b, c = 0;
    if (MODE == 1) { g = item & 31; b = item >> 5; row0 = P_ROWS + b * 4; T = 4; }
    else { g = item & 31; c = (item >> 5) & 31; b = item >> 10; row0 = b * SEQ + c * 128; T = 128; }
    const int gi = layer * 32 + g; const int n = lane;
    const float are = abar[(gi * 64 + n) * 2], aim = abar[(gi * 64 + n) * 2 + 1];
    float hre = 0.f, him = 0.f;
    if (MODE == 1) {
      hre = p.in[6][((size_t)(layer * 32 + b) * 32 + g) * 64 + n];
      him = p.in[7][((size_t)(layer * 32 + b) * 32 + g) * 64 + n];
    }
    if (MODE == 2) {
      const float tre = abart[(gi * 64 + n) * 2], tim = abart[(gi * 64 + n) * 2 + 1];
      for (int jb = 0; jb < c; jb += 8) {
        float er[8], ei[8];
#pragma unroll
        for (int q = 0; q < 8; ++q) {
          er[q] = 0.f; ei[q] = 0.f;
          if (jb + q < c) { const float* ep = Eb + (((size_t)(b * 32 + jb + q) * 32 + g) * 128); er[q] = ep[n]; ei[q] = ep[64 + n]; }
        }
#pragma unroll
        for (int q = 0; q < 8; ++q) {
          if (jb + q < c) {
            float nr = tre * hre - tim * him + er[q], ni = tre * him + tim * hre + ei[q];
            hre = nr; him = ni;
          }
        }
      }
    }
    bf16x8 bmf[8];
    if (MODE != 2) {
      for (int nt = 0; nt < 8; ++nt) {
        bf16x8 z = {0, 0, 0, 0, 0, 0, 0, 0};
        if (fq < 2) z = *(const bf16x8*)(bmt + ((size_t)gi * 128 + 16 * nt + fr) * 16 + fq * 8);
        bmf[nt] = z;
      }
    }
    bf16x8 cmf[4];
    for (int ks = 0; ks < 4; ++ks) cmf[ks] = *(const bf16x8*)(cmt + ((size_t)gi * 16 + fr) * 128 + 32 * ks + fq * 8);
    const int nsc = (T + 15) >> 4;
    bf16x8 uf_next = {0, 0, 0, 0, 0, 0, 0, 0};
    if (MODE != 2) { if (fq < 2 && fr < T) uf_next = *(const bf16x8*)(ub + (size_t)(row0 + fr) * DH + g * 16 + fq * 8); }
    for (int sc = 0; sc < nsc; ++sc) {
      float ylv[4] = {0.f, 0.f, 0.f, 0.f}, ubv[4] = {0.f, 0.f, 0.f, 0.f};
      if (MODE != 0) {
#pragma unroll
        for (int v = 0; v < 4; ++v) {
          const int t = 16 * sc + 4 * fq + v;
          if (t < T) {
            const size_t idx = (size_t)(row0 + t) * DH + g * 16 + fr;
            ubv[v] = bf2f(ub[idx]);
            if (MODE == 2) ylv[v] = yl[idx];
          }
        }
      }
      if (MODE != 2) {
        const bf16x8 uf = uf_next;
        uf_next = (bf16x8){0, 0, 0, 0, 0, 0, 0, 0};
        if (sc + 1 < nsc && fq < 2 && (16 * (sc + 1) + fr) < T) uf_next = *(const bf16x8*)(ub + (size_t)(row0 + 16 * (sc + 1) + fr) * DH + g * 16 + fq * 8);
        for (int nt = 0; nt < 8; ++nt) {
          f32x4 r = __builtin_amdgcn_mfma_f32_16x16x32_bf16(uf, bmf[nt], (f32x4){0.f, 0.f, 0.f, 0.f}, 0, 0, 0);
          for (int v = 0; v < 4; ++v) bu[(4 * fq + v) * 132 + 16 * nt + fr] = r[v];
        }
        LDS_FENCE();
      }
      for (int t = 0; t < 16; ++t) {
        if (16 * sc + t < T) {
          float br = 0.f, bi = 0.f;
          if (MODE != 2) { br = bu[t * 132 + n]; bi = bu[t * 132 + 64 + n]; }
          float nr = are * hre - aim * him + br, ni = are * him + aim * hre + bi;
          hre = nr; him = ni;
        }
        hb[t * 136 + n] = f2bf(hre); hb[t * 136 + 64 + n] = f2bf(him);
      }
      LDS_FENCE();
      f32x4 y = {0.f, 0.f, 0.f, 0.f};
      for (int ks = 0; ks < 4; ++ks) {
        bf16x8 a = *(const bf16x8*)(hb + fr * 136 + 32 * ks + fq * 8);
        y = __builtin_amdgcn_mfma_f32_16x16x32_bf16(a, cmf[ks], y, 0, 0, 0);
      }
      for (int v = 0; v < 4; ++v) {
        int t = 16 * sc + 4 * fq + v;
        if (t < T) {
          size_t idx = (size_t)(row0 + t) * DH + g * 16 + fr;
          if (MODE == 0) yl[idx] = y[v];
          else {
            float yy = y[v] + dsk[g * 16 + fr] * ubv[v];
            if (MODE == 2) yy += ylv[v];
            zb[idx] = f2bf(gelu_tanh(yy));
          }
        }
      }
      LDS_FENCE();
    }
    if (MODE == 0) {
      float* ep = Eb + (((size_t)(b * 32 + c) * 32 + g) * 128);
      ep[n] = hre; ep[64 + n] = him;
    } else if (MODE == 1) {
      p.out[O_RS + ((size_t)(layer * 32 + b) * 32 + g) * 64 + n] = hre;
      p.out[O_IS + ((size_t)(layer * 32 + b) * 32 + g) * 64 + n] = him;
    } else {
      if (c == 31) {
        const float* ep = Eb + (((size_t)(b * 32 + 31) * 32 + g) * 128);
        p.out[O_RP + ((size_t)(layer * 8 + b) * 32 + g) * 64 + n] = hre + ep[n];
        p.out[O_IP + ((size_t)(layer * 8 + b) * 32 + g) * 64 + n] = him + ep[64 + n];
      }
    }
  }
}

__device__ void attn_merge_phase(const Params& p, int layer) {
  IDS(); unsigned char* const WS = launder_p(p.ws);
  const u16* ob = (const u16*)(WS + WS_O); const float* lseb = (const float*)(WS + WS_LSE);
  u16* mix = (u16*)(WS + WS_MIX);
  const float* gain = p.in[12] + layer * DH;
  const int lane = TID & 63; const int gw = BID * 8 + (TID >> 6); const int nw = GDIM * 8;
  const int h = lane >> 3;
  float gn[8];
  for (int j = 0; j < 8; ++j) gn[j] = gain[lane * 8 + j];
  for (int row = gw; row < M_ROWS; row += nw) {
    float w0 = 1.f, w1 = 0.f, w2 = 0.f;
    uint4 a0 = *(const uint4*)(ob + ((size_t)0 * M_PAD + row) * DH + lane * 8);
    uint4 a1 = make_uint4(0, 0, 0, 0), a2 = make_uint4(0, 0, 0, 0);
    if (row < P_ROWS) {
      const int b = row >> 12, sq = row & 4095;
      const float l0 = lseb[(size_t)((0 * 8 + h) * 8 + b) * SEQ + sq];
      const float l1 = lseb[(size_t)((1 * 8 + h) * 8 + b) * SEQ + (sq & 3) * (SEQ / 4) + (sq >> 2)];
      const float l2 = lseb[(size_t)((2 * 8 + h) * 8 + b) * SEQ + (sq & 15) * (SEQ / 16) + (sq >> 4)];
      const float m = fmaxf(l0, fmaxf(l1, l2));
      w0 = __expf(l0 - m); w1 = __expf(l1 - m); w2 = __expf(l2 - m);
      const float inv = __builtin_amdgcn_rcpf(w0 + w1 + w2); w0 *= inv; w1 *= inv; w2 *= inv;
      a1 = *(const uint4*)(ob + ((size_t)1 * M_PAD + row) * DH + lane * 8);
      a2 = *(const uint4*)(ob + ((size_t)2 * M_PAD + row) * DH + lane * 8);
    }
    unsigned x0[4] = {a0.x, a0.y, a0.z, a0.w}, x1[4] = {a1.x, a1.y, a1.z, a1.w}, x2[4] = {a2.x, a2.y, a2.z, a2.w};
    float v[8]; float ss = 0.f;
    for (int j = 0; j < 4; ++j) {
      v[2 * j] = w0 * bf2f((u16)(x0[j] & 0xffff)) + w1 * bf2f((u16)(x1[j] & 0xffff)) + w2 * bf2f((u16)(x2[j] & 0xffff));
      v[2 * j + 1] = w0 * bf2f((u16)(x0[j] >> 16)) + w1 * bf2f((u16)(x1[j] >> 16)) + w2 * bf2f((u16)(x2[j] >> 16));
      ss += v[2 * j] * v[2 * j] + v[2 * j + 1] * v[2 * j + 1];
    }
    ss = wave_sum(ss);
    float rs = rsqrtf(ss * (1.f / DH) + EPS);
    uint4 o;
    o.x = pk2(v[0] * rs * gn[0], v[1] * rs * gn[1]);
    o.y = pk2(v[2] * rs * gn[2], v[3] * rs * gn[3]);
    o.z = pk2(v[4] * rs * gn[4], v[5] * rs * gn[5]);
    o.w = pk2(v[6] * rs * gn[6], v[7] * rs * gn[7]);
    *(uint4*)(mix + (size_t)row * DM + lane * 8) = o;
  }
}

__device__ void ssm_norm_phase(const Params& p, int layer) {
  IDS(); unsigned char* const WS = launder_p(p.ws);
  const float* go = (const float*)(WS + WS_O);
  u16* mix = (u16*)(WS + WS_MIX);
  const float* gain = p.in[13] + layer * DH;
  const int lane = TID & 63; const int gw = BID * 8 + (TID >> 6); const int nw = GDIM * 8;
  float gn[8];
  for (int j = 0; j < 8; ++j) gn[j] = gain[lane * 8 + j];
  for (int row = gw; row < M_ROWS; row += nw) {
    const float4* rp = (const float4*)(go + (size_t)row * DH + lane * 8);
    float4 a = rp[0], b = rp[1];
    float v[8] = {a.x, a.y, a.z, a.w, b.x, b.y, b.z, b.w};
    float ss = 0.f;
    for (int j = 0; j < 8; ++j) ss += v[j] * v[j];
    ss = wave_sum(ss);
    float rs = rsqrtf(ss * (1.f / DH) + EPS);
    uint4 o;
    o.x = pk2(v[0] * rs * gn[0], v[1] * rs * gn[1]);
    o.y = pk2(v[2] * rs * gn[2], v[3] * rs * gn[3]);
    o.z = pk2(v[4] * rs * gn[4], v[5] * rs * gn[5]);
    o.w = pk2(v[6] * rs * gn[6], v[7] * rs * gn[7]);
    *(uint4*)(mix + (size_t)row * DM + DH + lane * 8) = o;
  }
}


#define XB_TMO      128
#define XB_XCNT(j)  (256  + 64 * (j))
#define XB_XSUB(j)  (1280 + 64 * (j))
#define XB_XGEN(j)  (2304 + 64 * (j))
#define XB_TOP      3328
#define XB_TOPGEN   3392
#define XCD_BAR_WORDS 3456
#define XB_SPIN_CAP (1u << 18)
__device__ __forceinline__ unsigned xb_ld(unsigned* p)              { return __hip_atomic_load(p, __ATOMIC_RELAXED, __HIP_MEMORY_SCOPE_AGENT); }
__device__ __forceinline__ unsigned xb_add(unsigned* p, unsigned v) { return __hip_atomic_fetch_add(p, v, __ATOMIC_RELAXED, __HIP_MEMORY_SCOPE_AGENT); }
__device__ __forceinline__ unsigned xb_xcc_id() { return (unsigned)__builtin_amdgcn_s_getreg((3 << 11) | 20) & 0xFu; }
#define XB_SPIN(cond, bar) do { unsigned _sp = 0; while (cond) { __builtin_amdgcn_s_sleep(1); \
    if ((++_sp & 255u) == 0u) { if (xb_ld(&(bar)[XB_TMO])) break; if (_sp > XB_SPIN_CAP) { atomicAdd(&(bar)[XB_TMO], 1u); break; } } } } while (0)
__device__ __forceinline__ void xcd_barrier_complete(unsigned* bar, unsigned x, unsigned& nloc, unsigned& nx) {
  const unsigned G = gridDim.x;
  unsigned sum, cnt, mine, sp = 0u;
  for (;;) {
    sum = 0u; cnt = 0u; mine = 0u;
#pragma unroll
    for (unsigned j = 0; j < 16; ++j) { const unsigned c = xb_ld(&bar[XB_XCNT(j)]); sum += c; cnt += (c > 0u) ? 1u : 0u; mine = (j == x) ? c : mine; }
    if (sum == G) break;
    __builtin_amdgcn_s_sleep(1);
    if ((++sp & 255u) == 0u) { if (xb_ld(&bar[XB_TMO])) break; if (sp > XB_SPIN_CAP) { atomicAdd(&bar[XB_TMO], 1u); break; } }
  }
  nloc = mine > 0u ? mine : 1u; nx = cnt > 0u ? cnt : 1u;
}
__device__ __forceinline__ void xcd_barrier(unsigned* bar, volatile LAS unsigned* st) {
  asm volatile("s_waitcnt vmcnt(0)" ::: "memory");
  __syncthreads();
  if (threadIdx.x == 0) {
    const unsigned x = xb_xcc_id();
    __builtin_amdgcn_s_waitcnt(0);
    unsigned nloc = st[0], nx = st[1];
    if (nloc == 0u) { xcd_barrier_complete(bar, x, nloc, nx); st[0] = nloc; st[1] = nx; }
    const unsigned old = xb_add(&bar[XB_XSUB(x)], 1u);
    const unsigned gen = old / nloc;
    if (old + 1u == (gen + 1u) * nloc) {
      __builtin_amdgcn_fence(__ATOMIC_RELEASE, "agent");
      asm volatile("s_waitcnt vmcnt(0)" ::: "memory");
      const unsigned og = xb_add(&bar[XB_TOP], 1u);
      const unsigned tg = og / nx;
      if (og + 1u == (tg + 1u) * nx) xb_add(&bar[XB_TOPGEN], 1u);
      else XB_SPIN(xb_ld(&bar[XB_TOPGEN]) == tg, bar);
      __builtin_amdgcn_fence(__ATOMIC_ACQUIRE, "agent");
      xb_add(&bar[XB_XGEN(x)], 1u);
      asm volatile("s_waitcnt vmcnt(0)" ::: "memory");
    } else {
      XB_SPIN(xb_ld(&bar[XB_XGEN(x)]) == gen, bar);
      __builtin_amdgcn_fence(__ATOMIC_ACQUIRE, "agent");
      asm volatile("s_waitcnt vmcnt(0)" ::: "memory");
    }
  }
  __syncthreads();
}

__global__ void __launch_bounds__(512, 2) fwd_megakernel(Params p) {
  cg::grid_group grid = cg::this_grid();
  __shared__ uint4 xb_words;
  volatile LAS unsigned* xst = (volatile LAS unsigned*)&xb_words;
  if (threadIdx.x == 0) { xst[0] = 0u; xst[1] = 0u; xst[2] = 0u; xst[3] = 0u; (void)xb_add(&((unsigned*)(p.ws + WS_BAR))[XB_XCNT(xb_xcc_id())], 1u); }
  __syncthreads();
  if (blockIdx.x == 0 && threadIdx.x == 0) {
    Params* d = (Params*)(p.ws + WS_PTRS);
#pragma unroll
    for (int i = 0; i < 32; ++i) d->in[i] = p.in[i];
    d->out = p.out; d->ws = p.ws;
  }
  convert_weights(p);
  make_tables(p);
  copy_cache(p);
  prenorm_phase(p.in[0], p.in[1], p.in[14], (u16*)(p.ws + WS_H), (float*)(p.ws + WS_RSS));
  pconv_phase(p, 0);
  grid.sync();

#pragma nounroll
  for (int ph = 0; ph < 22; ++ph) {
    const int layer = ph / 11, k = ph % 11;
    unsigned char* const ws = launder_p(p.ws);
    const Params& LP = *(const Params*)(ws + WS_PTRS);
    float* xbuf = (float*)(ws + WS_X);
    u16* hbuf = (u16*)(ws + WS_H);
    float* rss = (float*)(ws + WS_RSS) + (size_t)layer * 4 * M_PAD * 32;
    constexpr size_t RS = (size_t)M_PAD * 32;
    const u16* Wl = (const u16*)(ws + WS_W) + (size_t)layer * LW_SIZE;
    switch (k) {
      case 0: case 8: {
        EpiArgs ea{}; ea.b0 = (u16*)(ws + WS_ACT); ea.rss_in = rss + (k == 0 ? 0 : 2) * RS;
        const u16* A = (k == 0 && layer == 1) ? (const u16*)(ws + WS_MIX) : hbuf;
        gemm_phase<EPI_GU>(A, Wl + (k == 0 ? LW_GU0 : LW_GU1), DM, 2 * DFF, ea);
      } break;
      case 1: case 7: case 9: {
        EpiArgs ea{}; ea.xout = xbuf; ea.hout = hbuf;
        if (layer == 0 && k == 1) { ea.xp = LP.in[0]; ea.xs = LP.in[1]; } else { ea.xp = xbuf; ea.xs = xbuf + (size_t)P_ROWS * DM; }
        ea.scale = (k == 7) ? 1.0f : 0.5f;
        ea.rss_out = rss + (k == 1 ? 1 : (k == 7 ? 2 : 3)) * RS;
        ea.gain_out = (k == 1) ? LP.in[11] + layer * DM : (k == 7 ? LP.in[14] + (layer * 2 + 1) * DM : LP.in[28] + layer * DM);
        const u16* A = (k == 7) ? (const u16*)(ws + WS_MIX) : (const u16*)(ws + WS_ACT);
        const u16* B = Wl + (k == 1 ? LW_D0 : (k == 7 ? LW_OUT : LW_D1));
        gemm_phase<EPI_RES>(A, B, (k == 7) ? DM : DFF, DM, ea);
      } break;
      case 2: {
        EpiArgs ea{}; ea.out = LP.out; ea.layer = layer; ea.rss_in = rss + RS;
        ea.b0 = (u16*)(ws + WS_Q); ea.b1 = (u16*)(ws + WS_K); ea.b2 = (u16*)(ws + WS_V); ea.b3 = (u16*)(ws + WS_U);
        gemm_phase<EPI_QKVU>(hbuf, Wl + LW_IN, DM, DIN, ea);
      } break;
      case 3:
        attn_sample_phase(LP, layer);
        __syncthreads();
        attn_prompt_phase(LP, layer);
        s5_phase<0>(LP, layer);
        s5_phase<1>(LP, layer);
        break;
      case 4:
        s5_phase<2>(LP, layer);
        attn_merge_phase(LP, layer);
        break;
      case 5: {
        EpiArgs ea{}; ea.zin = (const u16*)(ws + WS_Z); ea.aux = LP.in[27] + layer * DH; ea.fout = (float*)(ws + WS_O);
        gemm_phase<EPI_GLU>((const u16*)(ws + WS_Z), Wl + LW_GLU, DH, DH, ea);
      } break;
      case 6:
        ssm_norm_phase(LP, layer);
        if (layer == 1) pconv_phase(LP, 1);
        break;
      default: {
        EpiArgs ea{}; ea.fout = (float*)(ws + WS_ACT);
        gemm_phase<EPI_PROJ>((const u16*)(ws + WS_PBF), Wl + LW_PP, DPLE, DM, ea);
        EpiArgs eb{}; eb.fin = (const float*)(ws + WS_ACT); eb.xout = xbuf; eb.rss_in = rss + 3 * RS;
        if (layer == 0) { eb.gain_out = LP.in[14] + 2 * DM; eb.hout = (u16*)(ws + WS_MIX); eb.rss_out = rss + 4 * RS; }
        gemm_phase<EPI_PLE>(hbuf, Wl + LW_PG, DM, DM, eb);
      } break;
    }
    xcd_barrier((unsigned*)(launder_p(p.ws) + WS_BAR), xst);
    if (k == 1 || k == 7 || k == 9 || (k == 10 && layer == 0)) {
      const float* gn = (k == 1) ? LP.in[11] + layer * DM : (k == 7 ? LP.in[14] + (layer * 2 + 1) * DM : (k == 9 ? LP.in[28] + layer * DM : LP.in[14] + 2 * DM));
      float* ro = rss + (k == 1 ? 1 : (k == 7 ? 2 : (k == 9 ? 3 : 4))) * RS;
      prenorm_phase(xbuf, xbuf + (size_t)P_ROWS * DM, gn, k == 10 ? (u16*)(ws + WS_MIX) : hbuf, ro, P_ROWS);
      xcd_barrier((unsigned*)(launder_p(p.ws) + WS_BAR), xst);
    }
  }
  final_norm_phase(*(const Params*)(launder_p(p.ws) + WS_PTRS));
}

extern "C" void kernel_launch(void* const* d_in, const int* in_sizes, int n_in, void* d_out, int out_size,
                              void* d_ws, size_t ws_size, hipStream_t stream) {
  static int grid_blocks = 0;
  if (!grid_blocks) {
    int dev = 0, cus = 0, per_cu = 0;
    (void)hipGetDevice(&dev);
    (void)hipDeviceGetAttribute(&cus, hipDeviceAttributeMultiprocessorCount, dev);
    (void)hipFuncSetAttribute((const void*)fwd_megakernel, hipFuncAttributeMaxDynamicSharedMemorySize, LDS_BYTES);
    (void)hipOccupancyMaxActiveBlocksPerMultiprocessor(&per_cu, (const void*)fwd_megakernel, 512, LDS_BYTES);
    if (per_cu < 1) per_cu = 1;
    grid_blocks = cus * per_cu;
    if (ws_size < WS_END) { fprintf(stderr, "workspace too small: %zu < %zu\n", ws_size, (size_t)WS_END); grid_blocks = -1; }
  }
  if (grid_blocks < 0) return;
  Params p{};
  for (int i = 0; i < 32; ++i) p.in[i] = (const float*)d_in[i];
  p.out = (float*)d_out; p.ws = (unsigned char*)d_ws;
  (void)hipMemsetAsync((char*)d_ws + WS_BAR, 0, 16384, stream);
  void* args[] = {&p};
  hipError_t e = hipLaunchCooperativeKernel((const void*)fwd_megakernel, dim3(grid_blocks), dim3(512), args, LDS_BYTES, stream);
  if (e != hipSuccess) fprintf(stderr, "cooperative launch failed: %s (grid %d)\n", hipGetErrorString(e), grid_blocks);
}
```

```cpp
#include <hip/hip_runtime.h>
#include <hip/hip_bf16.h>
#include <hip/hip_cooperative_groups.h>
#include <cstdio>
namespace cg = cooperative_groups;

typedef unsigned short u16;
using bf16x8 = __attribute__((ext_vector_type(8))) short;
using f32x4 = __attribute__((ext_vector_type(4))) float;

constexpr int P_ROWS = 32768, S_ROWS = 128, M_ROWS = 32896, M_PAD = 33024;
constexpr int DM = 1024, DFF = 2816, DIN = 2048, DH = 512, DPLE = 256;
constexpr int SEQ = 4096;
constexpr float EPS = 1e-6f;

constexpr size_t O_YP = 0;
constexpr size_t O_YS = 33554432;
constexpr size_t O_KP = O_YS + 131072;
constexpr size_t O_VP = O_KP + 16777216;
constexpr size_t O_RP = O_VP + 16777216;
constexpr size_t O_IP = O_RP + 32768;
constexpr size_t O_KS = O_IP + 32768;
constexpr size_t O_VS = O_KS + 67108864;
constexpr size_t O_RS = O_VS + 67108864;
constexpr size_t O_IS = O_RS + 131072;

constexpr size_t LW_GU0 = 0, LW_D0 = 5767168, LW_GU1 = 8650752, LW_D1 = 14417920, LW_IN = 17301504,
                 LW_OUT = 19398656, LW_PG = 20447232, LW_PP = 21495808, LW_GLU = 21757952, LW_SIZE = 22020096;

constexpr size_t WS_W = 0;
constexpr size_t WS_X = WS_W + 2 * LW_SIZE * 2;
constexpr size_t WS_H = WS_X + (size_t)M_PAD * DM * 4;
constexpr size_t WS_MIX = WS_H + (size_t)M_PAD * DM * 2;
constexpr size_t WS_ACT = WS_MIX + (size_t)M_PAD * DM * 2;
constexpr size_t WS_Q = WS_ACT + (size_t)M_PAD * DFF * 2;
constexpr size_t WS_K = WS_Q + (size_t)M_PAD * DH * 2;
constexpr size_t WS_V = WS_K + (size_t)M_PAD * DH * 2;
constexpr size_t WS_U = WS_V + (size_t)M_PAD * DH * 2;
constexpr size_t WS_O = WS_U + (size_t)M_PAD * DH * 2;
constexpr size_t WS_LSE = WS_O + (size_t)3 * M_PAD * DH * 2;
constexpr size_t WS_YL = WS_LSE + (size_t)3 * M_PAD * 8 * 4;
constexpr size_t WS_Z = WS_YL + (size_t)M_PAD * DH * 4;
constexpr size_t WS_PBF = WS_Z + (size_t)M_PAD * DH * 2;
constexpr size_t WS_E = WS_PBF + (size_t)M_PAD * DPLE * 2;
constexpr size_t WS_ABAR = WS_E + (size_t)8 * 32 * 32 * 128 * 4;
constexpr size_t WS_ABART = WS_ABAR + 2 * 32 * 64 * 2 * 4;
constexpr size_t WS_BMT = WS_ABART + 2 * 32 * 64 * 2 * 4;
constexpr size_t WS_CMT = WS_BMT + 2 * 32 * 128 * 16 * 2;
constexpr size_t WS_BIAS = WS_CMT + 2 * 32 * 16 * 128 * 2;
constexpr size_t WS_RSS = WS_BIAS + 3 * 8 * 132 * 4 + 64;
constexpr size_t WS_PTRS = WS_RSS + (size_t)8 * M_PAD * 32 * 4;
constexpr size_t WS_BAR = WS_PTRS + 512;
constexpr size_t WS_END = WS_BAR + 16384;

constexpr int LDS_BYTES = 131072;

struct Params {
  const float* in[32];
  float* out;
  unsigned char* ws;
};

struct EpiArgs {
  const float* xp; const float* xs; float* xout;
  const float* aux; float* fout; const float* fin;
  u16* b0; u16* b1; u16* b2; u16* b3; const u16* zin;
  const float* rss_in; float* rss_out; const float* gain_out; u16* hout;
  float* out; float scale; int layer;
};

__device__ __forceinline__ unsigned pk2(float lo, float hi) { unsigned r; asm("v_cvt_pk_bf16_f32 %0, %1, %2" : "=v"(r) : "v"(lo), "v"(hi)); return r; }
__device__ __forceinline__ u16 f2bf(float f) { return (u16)(pk2(f, 0.f) & 0xffffu); }
__device__ __forceinline__ float bf2f(u16 h) { return __uint_as_float(((unsigned)h) << 16); }
__device__ __forceinline__ float sigmoidf_(float x) { return __builtin_amdgcn_rcpf(1.f + __expf(-x)); }
__device__ __forceinline__ float gelu_tanh(float x) {
  float t = 0.7978845608028654f * (x + 0.044715f * x * x * x);
  return x * __builtin_amdgcn_rcpf(1.f + __expf(-2.f * t));
}
__device__ __forceinline__ float wave_sum(float v) {
  for (int o = 32; o > 0; o >>= 1) v += __shfl_xor(v, o);
  return v;
}
__device__ __forceinline__ float wave_max(float v) {
  for (int o = 32; o > 0; o >>= 1) v = fmaxf(v, __shfl_xor(v, o));
  return v;
}
__device__ __forceinline__ int launder_v(int x) { asm volatile("" : "+v"(x)); return x; }
__device__ __forceinline__ int launder_s(int x) { x = __builtin_amdgcn_readfirstlane(x); asm volatile("" : "+s"(x)); return x; }
__device__ __forceinline__ unsigned char* launder_p(unsigned char* x) {
  unsigned long long v = (unsigned long long)x;
  unsigned lo = __builtin_amdgcn_readfirstlane((unsigned)v), hi = __builtin_amdgcn_readfirstlane((unsigned)(v >> 32));
  asm volatile("" : "+s"(lo), "+s"(hi));
  return (unsigned char*)(((unsigned long long)hi << 32) | lo);
}
#define IDS() const int TID = launder_v(threadIdx.x); const int BID = launder_s(blockIdx.x); const int GDIM = launder_s(gridDim.x); (void)TID; (void)BID; (void)GDIM
#define LDS_FENCE() asm volatile("s_waitcnt lgkmcnt(0)" ::: "memory")

enum { EPI_GU = 0, EPI_RES = 1, EPI_QKVU = 2, EPI_GLU = 3, EPI_PROJ = 4, EPI_PLE = 5 };
#define LAS __attribute__((address_space(3)))
constexpr int BM = 256, BK = 64, HALF = 128, HTB = HALF * BK * 2;

__device__ __forceinline__ int lds_byte(int r, int c) { const int st = (r >> 4) * 2 + (c >> 5), rr = r & 15, cc = c & 31, ob = rr * 64 + cc * 2; return st * 1024 + (ob ^ (((ob >> 9) & 1) << 5)); }
__device__ __forceinline__ void stage_rc(int b, int& R, int& C) { const int st = b / 1024, sb = b % 1024, swz = sb ^ (((sb >> 9) & 1) << 5); R = (st >> 1) * 16 + swz / 64; C = (st & 1) * 32 + (swz % 64) / 2; }

struct Unit { int pm, pn; };
struct Sched {
  int nN, nwg, G, c;
  __device__ __forceinline__ void init(int N) { nN = N >> 8; nwg = 128 * nN; G = gridDim.x; c = blockIdx.x; }
  __device__ __forceinline__ bool next(int i, Unit& u) const {
    const int L = i * G + c;
    if (L >= nwg) return false;
    const int q = nwg >> 3, xcd = L & 7, off = L >> 3;
    const int wgid = xcd * q + off;
    const int nig = 8 * nN, gid = wgid / nig, fm = gid * 8;
    u.pm = fm + ((wgid % nig) & 7); u.pn = (wgid % nig) >> 3; return true;
  }
};


__device__ __forceinline__ float row_rs(const float* rss, const int row, const int fq) {
  const f32x4* pr = (const f32x4*)(rss + ((size_t)fq * M_PAD + row) * 8);
  const f32x4 a = pr[0], b = pr[1];
  float sm = (a[0] + a[1]) + (a[2] + a[3]) + (b[0] + b[1]) + (b[2] + b[3]);
  sm += __shfl_xor(sm, 16); sm += __shfl_xor(sm, 32);
  return rsqrtf(sm * (1.f / DM) + EPS);
}

template <int EPI, bool WH = true>
__device__ __forceinline__ float epi_quad(const EpiArgs& ea, const int row, const int cb, f32x4 a0, f32x4 a1, const float rs) {
  float ss = 0.f;
  if constexpr (EPI == EPI_GU) {
    const int ac = ((cb & ~31) >> 1) + (cb & 31);
    float v[4];
#pragma unroll
    for (int j = 0; j < 4; ++j) { float g = a0[j] * rs; v[j] = g * sigmoidf_(g) * (a1[j] * rs); }
    uint2 o; o.x = pk2(v[0], v[1]); o.y = pk2(v[2], v[3]);
    *(uint2*)(ea.b0 + (size_t)row * DFF + ac) = o;
  } else if constexpr (EPI == EPI_RES) {
    const float* rp = row < P_ROWS ? ea.xp + (size_t)row * DM : ea.xs + (size_t)(row - P_ROWS) * DM;
    float* wp = ea.xout + (size_t)row * DM;
    f32x4 r0 = *(const f32x4*)(rp + cb), r1 = *(const f32x4*)(rp + cb + 16);
    r0 += ea.scale * a0; r1 += ea.scale * a1;
    *(f32x4*)(wp + cb) = r0; *(f32x4*)(wp + cb + 16) = r1;
    if constexpr (!WH) return 0.f;
    const f32x4 g0 = *(const f32x4*)(ea.gain_out + cb), g1 = *(const f32x4*)(ea.gain_out + cb + 16);
    uint2 o0, o1; o0.x = pk2(r0[0] * g0[0], r0[1] * g0[1]); o0.y = pk2(r0[2] * g0[2], r0[3] * g0[3]);
    o1.x = pk2(r1[0] * g1[0], r1[1] * g1[1]); o1.y = pk2(r1[2] * g1[2], r1[3] * g1[3]);
    *(uint2*)(ea.hout + (size_t)row * DM + cb) = o0; *(uint2*)(ea.hout + (size_t)row * DM + cb + 16) = o1;
#pragma unroll
    for (int j = 0; j < 4; ++j) ss += r0[j] * r0[j] + r1[j] * r1[j];
  } else if constexpr (EPI == EPI_QKVU) {
    a0 *= rs; a1 *= rs;
    const int seg = cb >> 9;
    const int cc = cb & 511;
    u16* dst = ea.b0 + (size_t)seg * ((size_t)M_PAD * DH);
    uint2 o0, o1; o0.x = pk2(a0[0], a0[1]); o0.y = pk2(a0[2], a0[3]); o1.x = pk2(a1[0], a1[1]); o1.y = pk2(a1[2], a1[3]);
    *(uint2*)(dst + (size_t)row * DH + cc) = o0;
    *(uint2*)(dst + (size_t)row * DH + cc + 16) = o1;
    if (seg == 1 || seg == 2) {
      size_t base; bool wrt = true;
      if (row < P_ROWS) {
        const int b = row >> 12, sq = row & 4095;
        wrt = sq >= 2048;
        base = (seg == 1 ? O_KP : O_VP) + ((size_t)(ea.layer * 8 + b) * 2048 + (sq - 2048)) * DH;
      } else {
        const int rs_ = row - P_ROWS; const int b = rs_ >> 2, t = rs_ & 3;
        base = (seg == 1 ? O_KS : O_VS) + ((size_t)(ea.layer * 32 + b) * 2048 + 2044 + t) * DH;
      }
      if (wrt) { *(f32x4*)(ea.out + base + cc) = a0; *(f32x4*)(ea.out + base + cc + 16) = a1; }
    }
  } else if constexpr (EPI == EPI_GLU) {
    const uint2 z0 = *(const uint2*)(ea.zin + (size_t)row * DH + cb), z1 = *(const uint2*)(ea.zin + (size_t)row * DH + cb + 16);
    const f32x4 b0 = *(const f32x4*)(ea.aux + cb), b1 = *(const f32x4*)(ea.aux + cb + 16);
    f32x4 o0, o1;
    o0[0] = bf2f((u16)(z0.x & 0xffff)) * sigmoidf_(a0[0] + b0[0]); o0[1] = bf2f((u16)(z0.x >> 16)) * sigmoidf_(a0[1] + b0[1]);
    o0[2] = bf2f((u16)(z0.y & 0xffff)) * sigmoidf_(a0[2] + b0[2]); o0[3] = bf2f((u16)(z0.y >> 16)) * sigmoidf_(a0[3] + b0[3]);
    o1[0] = bf2f((u16)(z1.x & 0xffff)) * sigmoidf_(a1[0] + b1[0]); o1[1] = bf2f((u16)(z1.x >> 16)) * sigmoidf_(a1[1] + b1[1]);
    o1[2] = bf2f((u16)(z1.y & 0xffff)) * sigmoidf_(a1[2] + b1[2]); o1[3] = bf2f((u16)(z1.y >> 16)) * sigmoidf_(a1[3] + b1[3]);
    *(f32x4*)(ea.fout + (size_t)row * DH + cb) = o0;
    *(f32x4*)(ea.fout + (size_t)row * DH + cb + 16) = o1;
  } else if constexpr (EPI == EPI_PROJ) {
    *(f32x4*)(ea.fout + (size_t)row * DM + cb) = a0;
    *(f32x4*)(ea.fout + (size_t)row * DM + cb + 16) = a1;
  } else if constexpr (EPI == EPI_PLE) {
    float* wp = ea.xout + (size_t)row * DM;
    const float* pp = ea.fin + (size_t)row * DM;
    f32x4 x0 = *(const f32x4*)(wp + cb), x1 = *(const f32x4*)(wp + cb + 16);
    const f32x4 p0 = *(const f32x4*)(pp + cb), p1 = *(const f32x4*)(pp + cb + 16);
#pragma unroll
    for (int j = 0; j < 4; ++j) { x0[j] += sigmoidf_(a0[j] * rs) * p0[j]; x1[j] += sigmoidf_(a1[j] * rs) * p1[j]; }
    *(f32x4*)(wp + cb) = x0; *(f32x4*)(wp + cb + 16) = x1;
    if (WH && ea.gain_out) {
      const f32x4 g0 = *(const f32x4*)(ea.gain_out + cb), g1 = *(const f32x4*)(ea.gain_out + cb + 16);
      uint2 o0, o1; o0.x = pk2(x0[0] * g0[0], x0[1] * g0[1]); o0.y = pk2(x0[2] * g0[2], x0[3] * g0[3]);
      o1.x = pk2(x1[0] * g1[0], x1[1] * g1[1]); o1.y = pk2(x1[2] * g1[2], x1[3] * g1[3]);
      *(uint2*)(ea.hout + (size_t)row * DM + cb) = o0; *(uint2*)(ea.hout + (size_t)row * DM + cb + 16) = o1;
#pragma unroll
      for (int j = 0; j < 4; ++j) ss += x0[j] * x0[j] + x1[j] * x1[j];
    }
  }
  return ss;
}

template <int EPI>
__device__ __forceinline__ void epilogue(const EpiArgs& ea, const f32x4 (&acc)[2][2][4][2], const Unit& u, int wr, int wc, int fr, int fq) {
  const int row0 = u.pm * BM + wr * 64 + fr;
  const int cb0 = u.pn * BM + wc * 32 + 4 * fq;
  if constexpr (EPI == EPI_RES || EPI == EPI_PLE) {
    const bool wh = (EPI == EPI_RES) || (ea.gain_out != nullptr);
    constexpr int RB = (EPI == EPI_RES) ? 2 : 1;
#pragma unroll
    for (int ai = 0; ai < 2; ++ai) {
#pragma unroll
      for (int mp = 0; mp < 4 / RB; ++mp) {
        f32x4 X[RB][2][2], PJ[RB][2][2], gn[2][2]; float rsv[RB];
#pragma unroll
        for (int mm = 0; mm < RB; ++mm) {
          const int row = row0 + ai * HALF + (RB * mp + mm) * 16;
          const float* rp = (EPI == EPI_RES) ? ea.xp + (size_t)row * DM : ea.xout + (size_t)row * DM;
#pragma unroll
          for (int bj = 0; bj < 2; ++bj)
#pragma unroll
            for (int n = 0; n < 2; ++n) {
              X[mm][bj][n] = __builtin_nontemporal_load((const f32x4*)(rp + cb0 + bj * HALF + 16 * n));
              if constexpr (EPI == EPI_PLE) PJ[mm][bj][n] = *(const f32x4*)(ea.fin + (size_t)row * DM + cb0 + bj * HALF + 16 * n);
            }
          if constexpr (EPI == EPI_PLE) rsv[mm] = row_rs(ea.rss_in, row, fq);
        }
#pragma unroll
        for (int bj = 0; bj < 2; ++bj)
#pragma unroll
          for (int n = 0; n < 2; ++n) gn[bj][n] = wh ? *(const f32x4*)(ea.gain_out + cb0 + bj * HALF + 16 * n) : (f32x4){0.f, 0.f, 0.f, 0.f};
#pragma unroll
        for (int mm = 0; mm < RB; ++mm) {
          const int m = RB * mp + mm;
          const int row = row0 + ai * HALF + m * 16;
          float* wp = ea.xout + (size_t)row * DM;
#pragma unroll
          for (int bj = 0; bj < 2; ++bj) {
            const int cb = cb0 + bj * HALF;
            f32x4 r0 = X[mm][bj][0], r1 = X[mm][bj][1];
            const f32x4 a0 = acc[ai][bj][m][0], a1 = acc[ai][bj][m][1];
            if constexpr (EPI == EPI_RES) { r0 += ea.scale * a0; r1 += ea.scale * a1; }
            else {
#pragma unroll
              for (int j = 0; j < 4; ++j) { r0[j] += sigmoidf_(a0[j] * rsv[mm]) * PJ[mm][bj][0][j]; r1[j] += sigmoidf_(a1[j] * rsv[mm]) * PJ[mm][bj][1][j]; }
            }
            __builtin_nontemporal_store(r0, (f32x4*)(wp + cb)); __builtin_nontemporal_store(r1, (f32x4*)(wp + cb + 16));
            if (wh) {
              uint2 o0, o1;
              o0.x = pk2(r0[0] * gn[bj][0][0], r0[1] * gn[bj][0][1]); o0.y = pk2(r0[2] * gn[bj][0][2], r0[3] * gn[bj][0][3]);
              o1.x = pk2(r1[0] * gn[bj][1][0], r1[1] * gn[bj][1][1]); o1.y = pk2(r1[2] * gn[bj][1][2], r1[3] * gn[bj][1][3]);
              *(uint2*)(ea.hout + (size_t)row * DM + cb) = o0; *(uint2*)(ea.hout + (size_t)row * DM + cb + 16) = o1;
              float ss = 0.f;
#pragma unroll
              for (int j = 0; j < 4; ++j) ss += r0[j] * r0[j] + r1[j] * r1[j];
              ss += __shfl_xor(ss, 16); ss += __shfl_xor(ss, 32);
              if (fq == 0) ea.rss_out[((size_t)u.pn * M_PAD + row) * 8 + bj * 4 + wc] = ss;
            }
          }
        }
      }
    }
  } else {
    float rsv[2][4];
#pragma unroll
    for (int ai = 0; ai < 2; ++ai)
#pragma unroll
      for (int m = 0; m < 4; ++m) {
        rsv[ai][m] = 1.f;
        if constexpr (EPI == EPI_GU || EPI == EPI_QKVU) rsv[ai][m] = row_rs(ea.rss_in, row0 + ai * HALF + m * 16, fq);
      }
#pragma unroll
    for (int ai = 0; ai < 2; ++ai) {
#pragma unroll
      for (int m = 0; m < 4; ++m) {
        const int row = row0 + ai * HALF + m * 16;
#pragma unroll
        for (int bj = 0; bj < 2; ++bj)
          (void)epi_quad<EPI>(ea, row, cb0 + bj * HALF, acc[ai][bj][m][0], acc[ai][bj][m][1], rsv[ai][m]);
      }
    }
  }
}

template <int EPI>
__device__ __forceinline__ void gemm_phase(const u16* gA, const u16* gBt, const int K, const int N, const EpiArgs& ea) {
  extern __shared__ __attribute__((aligned(16))) unsigned char smem[];
  LAS unsigned char* lds = (LAS unsigned char*)smem;
  IDS();
  Sched S; S.nN = N >> 8; S.nwg = 128 * S.nN; S.G = GDIM; S.c = BID;
  const int tid = TID, wid = __builtin_amdgcn_readfirstlane(tid >> 6), lane = tid & 63, wr = wid >> 2, wc = wid & 3, fr = lane & 15, fq = lane >> 4;
  const int nt = K / BK;
  for (int cg = BID; cg < (N >> 5); cg += GDIM) {
    const int c0 = cg * 32; const int row = P_ROWS + 16 * wid + fr;
    f32x4 c0a = {0.f, 0.f, 0.f, 0.f}, c1a = {0.f, 0.f, 0.f, 0.f};
    const u16* ap = gA + (size_t)row * K + 8 * fq; const u16* bp0 = gBt + (size_t)(c0 + fr) * K + 8 * fq; const u16* bp1 = bp0 + (size_t)16 * K;
    const int nks = K >> 5;
    int k0 = 0;
#define SK_CHUNK(C) { bf16x8 av[C], b0v[C], b1v[C]; \
      _Pragma("unroll") for (int u = 0; u < C; ++u) { av[u] = *(const bf16x8*)(ap + 32 * (k0 + u)); b0v[u] = *(const bf16x8*)(bp0 + 32 * (k0 + u)); b1v[u] = *(const bf16x8*)(bp1 + 32 * (k0 + u)); } \
      _Pragma("unroll") for (int u = 0; u < C; ++u) { c0a = __builtin_amdgcn_mfma_f32_16x16x32_bf16(b0v[u], av[u], c0a, 0, 0, 0); c1a = __builtin_amdgcn_mfma_f32_16x16x32_bf16(b1v[u], av[u], c1a, 0, 0, 0); } }
    for (; k0 + 16 <= nks; k0 += 16) SK_CHUNK(16)
    for (; k0 < nks; k0 += 8) SK_CHUNK(8)
#undef SK_CHUNK
    float rs = 1.f;
    if constexpr (EPI == EPI_GU || EPI == EPI_QKVU || EPI == EPI_PLE) rs = row_rs(ea.rss_in, row, fq);
    (void)epi_quad<EPI, false>(ea, row, c0 + 4 * fq, c0a, c1a, rs);
  }
  unsigned voffA[2];
#pragma unroll
  for (int i = 0; i < 2; ++i) { int R, C; stage_rc(tid * 16 + i * 8192, R, C); voffA[i] = (unsigned)(R * K + C) * 2u; }
  const size_t kstep = (size_t)(BK * 2);
  const size_t hstep = (size_t)HALF * K * 2;
  const size_t tstep = 2 * hstep;
  const unsigned ldsw = (unsigned)wid * 1024u;
  const int aoff = lds_byte(wr * 64 + fr, fq * 8), boff = lds_byte(wc * 32 + fr, fq * 8);
#define PG8_SA(b, h) (((b) * 2 + (h)) * HTB)
#define PG8_SB(b, h) ((4 + (b) * 2 + (h)) * HTB)
#define PG8_STAGE(bufoff, gbase, voff) do { _Pragma("unroll") for (int _i = 0; _i < 2; ++_i) \
        __builtin_amdgcn_global_load_lds((const unsigned*)((const char*)(gbase) + (voff)[_i]), (LAS unsigned*)(lds + (bufoff) + ldsw + _i * 8192), 16, 0, 0); } while (0)
#define PG8_LDA(dst, b, h) do { _Pragma("unroll") for (int m = 0; m < 4; ++m) _Pragma("unroll") for (int k = 0; k < 2; ++k) dst[m][k] = *(const LAS bf16x8*)(lds + PG8_SA(b, h) + aoff + m * 2048 + k * 1024); } while (0)
#define PG8_LDB(dst, b, h) do { _Pragma("unroll") for (int n = 0; n < 2; ++n) _Pragma("unroll") for (int k = 0; k < 2; ++k) dst[n][k] = *(const LAS bf16x8*)(lds + PG8_SB(b, h) + boff + n * 2048 + k * 1024); } while (0)
#define PG8_MMA(ai, bj, At, Bt) do { __builtin_amdgcn_s_setprio(1); _Pragma("unroll") for (int m = 0; m < 4; ++m) _Pragma("unroll") for (int n = 0; n < 2; ++n) _Pragma("unroll") for (int k = 0; k < 2; ++k) \
        acc[ai][bj][m][n] = __builtin_amdgcn_mfma_f32_16x16x32_bf16(Bt[n][k], At[m][k], acc[ai][bj][m][n], 0, 0, 0); __builtin_amdgcn_s_setprio(0); } while (0)
#define PG8_WAIT_V(n) asm volatile("s_waitcnt vmcnt(" #n ")" ::: "memory")
#define PG8_WAIT_L(n) asm volatile("s_waitcnt lgkmcnt(" #n ")" ::: "memory")
#define PG8_BAR __builtin_amdgcn_s_barrier()
#define PG8_SCHED __builtin_amdgcn_sched_barrier(0)
  Unit cur, nxt; int ui = 0;
  if (S.next(0, cur)) {
    f32x4 acc[2][2][4][2];
#pragma unroll
    for (int a = 0; a < 2; ++a)
#pragma unroll
      for (int b = 0; b < 2; ++b)
#pragma unroll
        for (int m = 0; m < 4; ++m)
#pragma unroll
          for (int n = 0; n < 2; ++n) acc[a][b][m][n] = (f32x4){0.f, 0.f, 0.f, 0.f};
    bf16x8 At[4][2], B0[2][2], B1[2][2];
    const char* cA = (const char*)gA + (size_t)cur.pm * tstep; const char* cB = (const char*)gBt + (size_t)cur.pn * tstep;
    PG8_STAGE(PG8_SB(0, 0), cB, voffA); PG8_STAGE(PG8_SA(0, 0), cA, voffA); PG8_STAGE(PG8_SB(0, 1), cB + hstep, voffA); PG8_STAGE(PG8_SA(0, 1), cA + hstep, voffA);
    if (wr == 1) PG8_BAR;
    PG8_WAIT_V(4); PG8_BAR;
    PG8_STAGE(PG8_SB(1, 0), cB + kstep, voffA); PG8_STAGE(PG8_SA(1, 0), cA + kstep, voffA); PG8_STAGE(PG8_SB(1, 1), cB + hstep + kstep, voffA);
    PG8_WAIT_V(6); PG8_BAR;
    for (;;) {
      const bool has_next = S.next(ui + 1, nxt);
      const char* nA = has_next ? (const char*)gA + (size_t)nxt.pm * tstep : cA; const char* nB = has_next ? (const char*)gBt + (size_t)nxt.pn * tstep : cB;
      for (int t = 0; t < nt; t += 2) {
        const bool last = (t == nt - 2);
        const char* a1 = cA + (size_t)(t + 1) * kstep;
        const char* a2 = last ? nA : cA + (size_t)(t + 2) * kstep; const char* b2 = last ? nB : cB + (size_t)(t + 2) * kstep;
        const char* a3 = a2 + kstep; const char* b3 = b2 + kstep;
        PG8_LDB(B0, 0, 0); PG8_SCHED; PG8_LDA(At, 0, 0); PG8_STAGE(PG8_SA(1, 1), a1 + hstep, voffA);
        PG8_WAIT_L(8); PG8_BAR; PG8_WAIT_L(0); PG8_MMA(0, 0, At, B0); PG8_BAR; PG8_SCHED;
        PG8_LDB(B1, 0, 1); PG8_STAGE(PG8_SB(0, 0), b2, voffA);
        PG8_BAR; PG8_WAIT_L(0); PG8_MMA(0, 1, At, B1); PG8_BAR;
        PG8_LDA(At, 0, 1); PG8_STAGE(PG8_SA(0, 0), a2, voffA);
        PG8_BAR; PG8_WAIT_L(0); PG8_MMA(1, 0, At, B0); PG8_BAR; PG8_SCHED;
        PG8_STAGE(PG8_SB(0, 1), b2 + hstep, voffA);
        PG8_WAIT_V(6); PG8_BAR; PG8_MMA(1, 1, At, B1); PG8_BAR;
        PG8_LDB(B0, 1, 0); PG8_SCHED; PG8_LDA(At, 1, 0); PG8_STAGE(PG8_SA(0, 1), a2 + hstep, voffA);
        PG8_WAIT_L(8); PG8_BAR; PG8_WAIT_L(0); PG8_MMA(0, 0, At, B0); PG8_BAR; PG8_SCHED;
        PG8_LDB(B1, 1, 1); PG8_STAGE(PG8_SB(1, 0), b3, voffA);
        PG8_BAR; PG8_WAIT_L(0); PG8_MMA(0, 1, At, B1); PG8_BAR;
        PG8_LDA(At, 1, 1); PG8_STAGE(PG8_SA(1, 0), a3, voffA);
        PG8_BAR; PG8_WAIT_L(0); PG8_MMA(1, 0, At, B0); PG8_BAR; PG8_SCHED;
        PG8_STAGE(PG8_SB(1, 1), b3 + hstep, voffA);
        PG8_WAIT_V(6); PG8_BAR; PG8_MMA(1, 1, At, B1); PG8_BAR;
      }
      epilogue<EPI>(ea, acc, cur, wr, wc, fr, fq);
      if (!has_next) break;
#pragma unroll
      for (int a = 0; a < 2; ++a)
#pragma unroll
        for (int b = 0; b < 2; ++b)
#pragma unroll
          for (int m = 0; m < 4; ++m)
#pragma unroll
            for (int n = 0; n < 2; ++n) acc[a][b][m][n] = (f32x4){0.f, 0.f, 0.f, 0.f};
      cur = nxt; cA = nA; cB = nB; ++ui;
    }
    PG8_WAIT_V(0);
    if (wr == 0) PG8_BAR;
    PG8_BAR;
  }
  __syncthreads();
#undef PG8_SA
#undef PG8_SB
#undef PG8_STAGE
#undef PG8_LDA
#undef PG8_LDB
#undef PG8_MMA
}

struct CvtJob { const float* sp; u16* dp; };
__device__ __forceinline__ CvtJob cvt_job(const Params& p, u16* W, const int t, const int tid) {
  int layer = t / 5376, r = t % 5376;
  const float* src; u16* dst; int K, N, mode = 0;
  u16* Wl = W + (size_t)layer * LW_SIZE;
  if (r < 4224) {
    int j = r / 2112; int rr = r % 2112; int which = rr / 704; r = rr % 704;
    size_t so = (size_t)(layer * 2 + j) * (size_t)DM * DFF;
    if (which == 0) { src = p.in[15] + so; K = DM; N = DFF; mode = 1; dst = Wl + (j ? LW_GU1 : LW_GU0); }
    else if (which == 1) { src = p.in[16] + so; K = DM; N = DFF; mode = 2; dst = Wl + (j ? LW_GU1 : LW_GU0); }
    else { src = p.in[17] + so; K = DFF; N = DM; dst = Wl + (j ? LW_D1 : LW_D0); }
  } else if (r < 4736) { r -= 4224; src = p.in[9] + (size_t)layer * DM * DIN; K = DM; N = DIN; dst = Wl + LW_IN; }
  else if (r < 4992) { r -= 4736; src = p.in[10] + (size_t)layer * DM * DM; K = DM; N = DM; dst = Wl + LW_OUT; }
  else if (r < 5248) { r -= 4992; src = p.in[29] + (size_t)layer * DM * DM; K = DM; N = DM; dst = Wl + LW_PG; }
  else if (r < 5312) { r -= 5248; src = p.in[30] + (size_t)layer * DPLE * DM; K = DPLE; N = DM; dst = Wl + LW_PP; }
  else { r -= 5312; src = p.in[26] + (size_t)layer * DH * DH; K = DH; N = DH; dst = Wl + LW_GLU; }
  const int ntn = N >> 6; const int kt = r / ntn, nt = r % ntn;
  CvtJob jb;
  { const int kr = tid >> 3, c8 = (tid & 7) * 8; jb.sp = src + (size_t)(kt * 64 + kr) * N + nt * 64 + c8; }
  { const int n = tid >> 3, k0 = (tid & 7) * 8; const int c = nt * 64 + n; int drow = c;
    if (mode == 1) drow = 32 * (c >> 4) + (c & 15); else if (mode == 2) drow = 32 * (c >> 4) + 16 + (c & 15);
    jb.dp = dst + (size_t)drow * K + kt * 64 + k0; }
  return jb;
}
__device__ void convert_weights(const Params& p) {
  IDS(); unsigned char* const WS = launder_p(p.ws);
  extern __shared__ __attribute__((aligned(16))) unsigned char smem[];
  float* tiles = (float*)smem;
  u16* W = (u16*)(WS + WS_W);
  const int tid = TID;
  const int total = 2 * 5376;
  float4 v0 = make_float4(0.f, 0.f, 0.f, 0.f), v1 = v0; u16* dcur = nullptr;
  if (BID < total) { const CvtJob jb = cvt_job(p, W, BID, tid); v0 = ((const float4*)jb.sp)[0]; v1 = ((const float4*)jb.sp)[1]; dcur = jb.dp; }
  int buf = 0;
  for (int t = BID; t < total; t += GDIM) {
    float* tile = tiles + buf * (64 * 65);
    {
      const int kr = tid >> 3, c8 = (tid & 7) * 8;
      float* tp = tile + kr * 65 + c8;
      tp[0] = v0.x; tp[1] = v0.y; tp[2] = v0.z; tp[3] = v0.w; tp[4] = v1.x; tp[5] = v1.y; tp[6] = v1.z; tp[7] = v1.w;
    }
    __syncthreads();
    u16* const dnow = dcur;
    if (t + GDIM < total) { const CvtJob jb = cvt_job(p, W, t + GDIM, tid); v0 = ((const float4*)jb.sp)[0]; v1 = ((const float4*)jb.sp)[1]; dcur = jb.dp; }
    {
      const int n = tid >> 3, k0 = (tid & 7) * 8;
      uint4 o;
      o.x = pk2(tile[(k0 + 0) * 65 + n], tile[(k0 + 1) * 65 + n]); o.y = pk2(tile[(k0 + 2) * 65 + n], tile[(k0 + 3) * 65 + n]);
      o.z = pk2(tile[(k0 + 4) * 65 + n], tile[(k0 + 5) * 65 + n]); o.w = pk2(tile[(k0 + 6) * 65 + n], tile[(k0 + 7) * 65 + n]);
      *(uint4*)dnow = o;
    }
    buf ^= 1;
  }
  __syncthreads();
}

__device__ void make_tables(const Params& p) {
  IDS(); unsigned char* const WS = launder_p(p.ws);
  int gt = BID * 512 + TID;
  if (gt < 4096) {
    int layer = gt >> 11, g = (gt >> 6) & 31, n = gt & 63;
    int gi = layer * 32 + g;
    double dt = exp((double)p.in[20][gi]);
    double are = p.in[18][gi * 64 + n], aim = p.in[19][gi * 64 + n];
    double mag = exp(are * dt), ar = mag * cos(aim * dt), ai = mag * sin(aim * dt);
    float* abar = (float*)(WS + WS_ABAR); float* abart = (float*)(WS + WS_ABART);
    abar[(gi * 64 + n) * 2] = (float)ar; abar[(gi * 64 + n) * 2 + 1] = (float)ai;
    double pr = ar, pi = ai;
    for (int s = 0; s < 7; ++s) { double nr = pr * pr - pi * pi, ni = 2 * pr * pi; pr = nr; pi = ni; }
    abart[(gi * 64 + n) * 2] = (float)pr; abart[(gi * 64 + n) * 2 + 1] = (float)pi;
    double nr_ = ar - 1.0, ni_ = ai; double den = are * are + aim * aim;
    double cr = (nr_ * are + ni_ * aim) / den, ci = (ni_ * are - nr_ * aim) / den;
    u16* bmt = (u16*)(WS + WS_BMT); u16* cmt = (u16*)(WS + WS_CMT);
    for (int i = 0; i < 16; ++i) {
      double br = p.in[21][(gi * 64 + n) * 16 + i], bi = p.in[22][(gi * 64 + n) * 16 + i];
      bmt[((size_t)gi * 128 + n) * 16 + i] = f2bf((float)(cr * br - ci * bi));
      bmt[((size_t)gi * 128 + 64 + n) * 16 + i] = f2bf((float)(cr * bi + ci * br));
    }
    for (int o = 0; o < 16; ++o) {
      cmt[((size_t)gi * 16 + o) * 128 + n] = f2bf(p.in[23][(gi * 16 + o) * 64 + n]);
      cmt[((size_t)gi * 16 + o) * 128 + 64 + n] = f2bf(-p.in[24][(gi * 16 + o) * 64 + n]);
    }
  }
  if (gt >= 4096 && gt < 4096 + 3 * 129) {
    int q = gt - 4096; int g = q / 129, j = q % 129; int d = g == 0 ? 1 : (g == 1 ? 4 : 16);
    int dist = j * d; int bk;
    if (dist < 16) bk = dist;
    else { bk = 16 + (int)(log((double)dist / 16.0) / log(128.0) * 16.0); if (bk > 31) bk = 31; }
    float* bias = (float*)(WS + WS_BIAS);
    for (int h = 0; h < 8; ++h) bias[(g * 8 + h) * 132 + j] = p.in[8][bk * 8 + h];
  }
}

__device__ void copy_cache(const Params& p) {
  IDS();
  const size_t per = 2044 * 512 / 4;
  const size_t total = per * 64 * 2;
  const size_t stride = (size_t)GDIM * 512;
  for (size_t i0 = (size_t)BID * 512 + TID; i0 < total; i0 += 4 * stride) {
    f32x4 v[4];
#pragma unroll
    for (int q = 0; q < 4; ++q) {
      size_t i = i0 + q * stride;
      if (i < total) {
        size_t seg = i / per, off = i % per; int kv = (int)(seg >> 6); size_t sb = seg & 63;
        v[q] = __builtin_nontemporal_load((const f32x4*)(p.in[4 + kv] + sb * (2048 * 512) + 4 * 512) + off);
      }
    }
#pragma unroll
    for (int q = 0; q < 4; ++q) {
      size_t i = i0 + q * stride;
      if (i < total) {
        size_t seg = i / per, off = i % per; int kv = (int)(seg >> 6); size_t sb = seg & 63;
        __builtin_nontemporal_store(v[q], (f32x4*)(p.out + (kv ? O_VS : O_KS) + sb * (2048 * 512)) + off);
      }
    }
  }
}

__device__ void prenorm_phase(const float* xp, const float* xs, const float* gain, u16* dst, float* rss, const int row_lo = 0) {
  IDS();
  const int lane = TID & 63; const int gw = BID * 8 + (TID >> 6); const int nw = GDIM * 8;
  float4 g[4];
  for (int i = 0; i < 4; ++i) g[i] = ((const float4*)gain)[i * 64 + lane];
  for (int row = row_lo + gw; row < M_ROWS; row += nw) {
    const float4* rp = (const float4*)(row < P_ROWS ? xp + (size_t)row * DM : xs + (size_t)(row - P_ROWS) * DM);
    float4 v[4]; float ss = 0.f;
    for (int i = 0; i < 4; ++i) { v[i] = rp[i * 64 + lane]; ss += v[i].x * v[i].x + v[i].y * v[i].y + v[i].z * v[i].z + v[i].w * v[i].w; }
    ss = wave_sum(ss);
    if (lane < 32) rss[((size_t)(lane >> 3) * M_PAD + row) * 8 + (lane & 7)] = lane == 0 ? ss : 0.f;
    for (int i = 0; i < 4; ++i) {
      uint2 o;
      o.x = pk2(v[i].x * g[i].x, v[i].y * g[i].y);
      o.y = pk2(v[i].z * g[i].z, v[i].w * g[i].w);
      *(uint2*)(dst + (size_t)row * DM + (i * 64 + lane) * 4) = o;
    }
  }
}

__device__ void final_norm_phase(const Params& p) {
  IDS(); unsigned char* const WS = launder_p(p.ws);
  const float* x = (const float*)(WS + WS_X); const float* gain = p.in[31];
  const int lane = TID & 63; const int gw = BID * 8 + (TID >> 6); const int nw = GDIM * 8;
  float4 g[4];
  for (int i = 0; i < 4; ++i) g[i] = ((const float4*)gain)[i * 64 + lane];
  for (int row = gw; row < M_ROWS; row += nw) {
    const float4* rp = (const float4*)(x + (size_t)row * DM);
    float4 v[4]; float ss = 0.f;
    for (int i = 0; i < 4; ++i) { v[i] = rp[i * 64 + lane]; ss += v[i].x * v[i].x + v[i].y * v[i].y + v[i].z * v[i].z + v[i].w * v[i].w; }
    ss = wave_sum(ss);
    float rs = rsqrtf(ss * (1.f / DM) + EPS);
    float4* op = (float4*)(p.out + (row < P_ROWS ? O_YP + (size_t)row * DM : O_YS + (size_t)(row - P_ROWS) * DM));
    for (int i = 0; i < 4; ++i) {
      float4 o; o.x = v[i].x * rs * g[i].x; o.y = v[i].y * rs * g[i].y; o.z = v[i].z * rs * g[i].z; o.w = v[i].w * rs * g[i].w;
      op[i * 64 + lane] = o;
    }
  }
}

__device__ void pconv_phase(const Params& p, int layer) {
  IDS(); unsigned char* const WS = launder_p(p.ws);
  u16* pbf = (u16*)(WS + WS_PBF);
  const size_t total = (size_t)M_ROWS * DPLE / 4;
  const float* pp = p.in[2] + (size_t)layer * P_ROWS * DPLE;
  const float* ps = p.in[3] + (size_t)layer * S_ROWS * DPLE;
  for (size_t i = (size_t)BID * 512 + TID; i < total; i += (size_t)GDIM * 512) {
    size_t e = i * 4;
    float4 v = e < (size_t)P_ROWS * DPLE ? *(const float4*)(pp + e) : *(const float4*)(ps + (e - (size_t)P_ROWS * DPLE));
    uint2 o; o.x = pk2(v.x, v.y); o.y = pk2(v.z, v.w);
    *(uint2*)(pbf + e) = o;
  }
}

__device__ void attn_prompt_phase(const Params& p, int layer) {
  IDS(); unsigned char* const WS = launder_p(p.ws);
  extern __shared__ __attribute__((aligned(16))) unsigned char smem[];
  u16* Ks = (u16*)smem;
  u16* Vt = Ks + 256 * 72;
  const u16* qb = (const u16*)(WS + WS_Q); const u16* kb = (const u16*)(WS + WS_K); const u16* vb = (const u16*)(WS + WS_V);
  u16* ob = (u16*)(WS + WS_O); float* lseb = (float*)(WS + WS_LSE);
  const float* biasT = (const float*)(WS + WS_BIAS);
  const int tid = TID, w = tid >> 6, lane = tid & 63, fr = lane & 15, fq = lane >> 4;
  int cached_gh = -1; float bv[9][4];
  const bool bal = (GDIM == 256);
  const int njobs = bal ? (BID < 128 ? 19 : 29) : (6144 - BID + GDIM - 1) / GDIM;
  for (int jj = 0; jj < njobs; ++jj) {
    const int item = (bal && jj >= 24) ? (BID - 128) + 256 * (jj - 5) : BID + GDIM * jj;
    int h = item & 7; int t = item >> 3;
    int g = t >> 8; int u = t & 255;
    int d = (g == 0) ? 1 : (g == 1 ? 4 : 16);
    int nqb = 32 / d;
    int qblk = u % nqb; int br = u / nqb; int r = br % d; int b = br / d;
    int i0 = qblk * 128;
    {
      const int kg = tid >> 3, ch = tid & 7;
      uint4 kq[4], vq[4];
#pragma unroll
      for (int it = 0; it < 4; ++it) {
        const int kr = 4 * kg + it; const int ip = i0 - 128 + kr;
        kq[it] = make_uint4(0, 0, 0, 0); vq[it] = make_uint4(0, 0, 0, 0);
        if (ip >= 0) {
          const size_t row = (size_t)b * SEQ + r + d * ip;
          kq[it] = *(const uint4*)(kb + row * DH + h * 64 + ch * 8);
          vq[it] = *(const uint4*)(vb + row * DH + h * 64 + ch * 8);
        }
      }
#pragma unroll
      for (int it = 0; it < 4; ++it) *(uint4*)(Ks + (4 * kg + it) * 72 + ch * 8) = kq[it];
      const int pcol = (4 * kg) ^ ((ch & 1) << 5);
      const unsigned vw[4][4] = {{vq[0].x, vq[0].y, vq[0].z, vq[0].w}, {vq[1].x, vq[1].y, vq[1].z, vq[1].w},
                                 {vq[2].x, vq[2].y, vq[2].z, vq[2].w}, {vq[3].x, vq[3].y, vq[3].z, vq[3].w}};
#pragma unroll
      for (int j2 = 0; j2 < 4; ++j2) {
        uint2 ev, od;
        ev.x = (vw[0][j2] & 0xffffu) | (vw[1][j2] << 16); ev.y = (vw[2][j2] & 0xffffu) | (vw[3][j2] << 16);
        od.x = (vw[0][j2] >> 16) | (vw[1][j2] & 0xffff0000u); od.y = (vw[2][j2] >> 16) | (vw[3][j2] & 0xffff0000u);
        *(uint2*)(Vt + (ch * 8 + 2 * j2) * 264 + pcol) = ev;
        *(uint2*)(Vt + (ch * 8 + 2 * j2 + 1) * 264 + pcol) = od;
      }
    }
    __syncthreads();
    int iq = i0 + 16 * w + fr; size_t qrow = (size_t)b * SEQ + r + d * iq;
    bf16x8 qf[2];
    for (int kk = 0; kk < 2; ++kk) qf[kk] = *(const bf16x8*)(qb + qrow * DH + h * 64 + kk * 32 + fq * 8);
    f32x4 s[9];
    for (int kt = 0; kt < 9; ++kt) {
      s[kt] = (f32x4){0.f, 0.f, 0.f, 0.f};
      for (int kk = 0; kk < 2; ++kk) {
        bf16x8 a = *(const bf16x8*)(Ks + (16 * w + 16 * kt + fr) * 72 + kk * 32 + fq * 8);
        s[kt] = __builtin_amdgcn_mfma_f32_16x16x32_bf16(a, qf[kk], s[kt], 0, 0, 0);
      }
    }
    if (g * 8 + h != cached_gh) {
      cached_gh = g * 8 + h;
      const float* bT = biasT + (g * 8 + h) * 132;
#pragma unroll
      for (int kt = 0; kt < 9; ++kt)
#pragma unroll
        for (int v = 0; v < 4; ++v) {
          const int step = 128 + fr - 16 * kt - 4 * fq - v;
          const int sc = step < 0 ? 0 : (step > 128 ? 128 : step);
          const float bb = bT[sc] * 1.4426950408889634f;
          bv[kt][v] = (step >= 0 && step <= 128) ? bb : -1e30f;
        }
    }
    float mx = -3e38f;
    if (i0 == 0) {
#pragma unroll
      for (int kt = 0; kt < 9; ++kt)
#pragma unroll
        for (int v = 0; v < 4; ++v) {
          const int ip = 16 * w - 128 + 16 * kt + 4 * fq + v;
          const float lg = (ip >= 0) ? s[kt][v] * (0.125f * 1.4426950408889634f) + bv[kt][v] : -1e30f;
          s[kt][v] = lg; mx = fmaxf(mx, lg);
        }
    } else {
#pragma unroll
      for (int kt = 0; kt < 9; ++kt)
#pragma unroll
        for (int v = 0; v < 4; ++v) { const float lg = s[kt][v] * (0.125f * 1.4426950408889634f) + bv[kt][v]; s[kt][v] = lg; mx = fmaxf(mx, lg); }
    }
    mx = fmaxf(mx, __shfl_xor(mx, 16)); mx = fmaxf(mx, __shfl_xor(mx, 32));
    float sum = 0.f;
    for (int kt = 0; kt < 9; ++kt) for (int v = 0; v < 4; ++v) { float e = __builtin_amdgcn_exp2f(s[kt][v] - mx); s[kt][v] = e; sum += e; }
    sum += __shfl_xor(sum, 16); sum += __shfl_xor(sum, 32);
    f32x4 o[4];
    for (int mt = 0; mt < 4; ++mt) o[mt] = (f32x4){0.f, 0.f, 0.f, 0.f};
    for (int ks = 0; ks < 5; ++ks) {
      union { uint4 u; bf16x8 v; } pu;
      pu.u.x = pk2(s[2 * ks][0], s[2 * ks][1]); pu.u.y = pk2(s[2 * ks][2], s[2 * ks][3]);
      if (ks < 4) { pu.u.z = pk2(s[2 * ks + 1][0], s[2 * ks + 1][1]); pu.u.w = pk2(s[2 * ks + 1][2], s[2 * ks + 1][3]); }
      else { pu.u.z = 0u; pu.u.w = 0u; }
      const bf16x8 pf = pu.v;
      for (int mt = 0; mt < 4; ++mt) {
        const int swz = ((fr >> 3) & 1) << 5;
        const u16* vrow = Vt + (16 * mt + fr) * 264;
        uint2 lo = *(const uint2*)(vrow + ((16 * w + 32 * ks + 4 * fq) ^ swz));
        uint2 hi = make_uint2(0, 0);
        if (ks < 4) hi = *(const uint2*)(vrow + ((16 * w + 32 * ks + 16 + 4 * fq) ^ swz));
        union { uint4 u; bf16x8 v; } cv; cv.u = make_uint4(lo.x, lo.y, hi.x, hi.y);
        o[mt] = __builtin_amdgcn_mfma_f32_16x16x32_bf16(cv.v, pf, o[mt], 0, 0, 0);
      }
    }
    float inv = 1.f / sum;
    u16* op = ob + ((size_t)g * M_PAD + qrow) * DH + h * 64;
    for (int mt = 0; mt < 4; ++mt) {
      uint2 ov;
      ov.x = pk2(o[mt][0] * inv, o[mt][1] * inv);
      ov.y = pk2(o[mt][2] * inv, o[mt][3] * inv);
      *(uint2*)(op + 16 * mt + 4 * fq) = ov;
    }
    if (fq == 0) lseb[(size_t)((g * 8 + h) * 8 + b) * SEQ + r * (SEQ / d) + iq] = (mx + __log2f(sum)) * 0.6931471805599453f;
    __syncthreads();
  }
}

__device__ void attn_sample_phase(const Params& p, int layer) {
  IDS(); unsigned char* const WS = launder_p(p.ws);
  extern __shared__ __attribute__((aligned(16))) unsigned char smem[];
  const int tid = TID, w = tid >> 6, lane = tid & 63;
  float* pl = (float*)smem + w * 1024;
  int* el = (int*)(pl + 448);
  float* ql = pl + 896;
  const u16* qb = (const u16*)(WS + WS_Q);
  u16* ob = (u16*)(WS + WS_O); float* lseb = (float*)(WS + WS_LSE);
  const float* biasT = (const float*)(WS + WS_BIAS);
  for (int item = BID * 8 + w; item < 1024; item += GDIM * 8) {
    int h = item & 7, t = (item >> 3) & 3, b = item >> 5;
    int row = P_ROWS + b * 4 + t;
    ql[lane] = bf2f(qb[(size_t)row * DH + h * 64 + lane]);
    LDS_FENCE();
    const float* ck = p.in[4] + (size_t)(layer * 32 + b) * 2048 * 512 + h * 64;
    const float* cv = p.in[5] + (size_t)(layer * 32 + b) * 2048 * 512 + h * 64;
    const float* nk = p.out + O_KS + ((size_t)(layer * 32 + b) * 2048 + 2044) * 512 + h * 64;
    const float* nv = p.out + O_VS + ((size_t)(layer * 32 + b) * 2048 + 2044) * 512 + h * 64;
    float mx = -3e38f;
#pragma unroll 2
    for (int i = 0; i < 7; ++i) {
      int s = lane + 64 * i; float l = -1e30f; int e = 0;
      if (s < 387) {
        int g = s / 129, j = s - 129 * g; int d = g == 0 ? 1 : (g == 1 ? 4 : 16);
        e = 2048 + t - j * d;
        const float4* kr = (const float4*)(e >= 2048 ? nk + (size_t)(e - 2048) * 512 : ck + (size_t)e * 512);
        float dot = 0.f;
#pragma unroll
        for (int c = 0; c < 16; ++c) { float4 kv = kr[c]; float4 qv = ((const float4*)ql)[c]; dot += kv.x * qv.x + kv.y * qv.y + kv.z * qv.z + kv.w * qv.w; }
        l = dot * 0.125f + biasT[(g * 8 + h) * 132 + j];
      }
      mx = fmaxf(mx, l); pl[s] = l; el[s] = e;
    }
    mx = wave_max(mx);
    float sum = 0.f;
#pragma unroll
    for (int i = 0; i < 7; ++i) { float ev = __expf(pl[lane + 64 * i] - mx); pl[lane + 64 * i] = ev; sum += ev; }
    sum = wave_sum(sum);
    const float inv = 1.f / sum;
    LDS_FENCE();
    const int sg = lane >> 4, d4 = lane & 15;
    f32x4 acc = {0.f, 0.f, 0.f, 0.f};
#pragma unroll 16
    for (int it = 0; it < 97; ++it) {
      const int s = 4 * it + sg;
      const float pw = pl[s]; const int e = el[s];
      const float* vr = e >= 2048 ? nv + (size_t)(e - 2048) * 512 : cv + (size_t)e * 512;
      const f32x4 vv = *(const f32x4*)(vr + 4 * d4);
      acc += pw * vv;
    }
#pragma unroll
    for (int j = 0; j < 4; ++j) { acc[j] += __shfl_xor(acc[j], 16); acc[j] += __shfl_xor(acc[j], 32); }
    LDS_FENCE();
    if (sg == 0) {
      uint2 o; o.x = pk2(acc[0] * inv, acc[1] * inv); o.y = pk2(acc[2] * inv, acc[3] * inv);
      *(uint2*)(ob + ((size_t)0 * M_PAD + row) * DH + h * 64 + 4 * d4) = o;
    }
  }
}

template <int MODE>
__device__ void s5_phase(const Params& p, int layer) {
  IDS(); unsigned char* const WS = launder_p(p.ws);
  extern __shared__ __attribute__((aligned(16))) unsigned char smem[];
  const int tid = TID, w = tid >> 6, lane = tid & 63, fr = lane & 15, fq = lane >> 4;
  float* bu = (float*)(smem + w * 12800);
  u16* hb = (u16*)(smem + w * 12800 + 8448);
  const u16* ub = (const u16*)(WS + WS_U);
  float* yl = (float*)(WS + WS_YL); u16* zb = (u16*)(WS + WS_Z); float* Eb = (float*)(WS + WS_E);
  const float* abar = (const float*)(WS + WS_ABAR); const float* abart = (const float*)(WS + WS_ABART);
  const u16* bmt = (const u16*)(WS + WS_BMT); const u16* cmt = (const u16*)(WS + WS_CMT);
  const float* dsk = p.in[25] + layer * DH;
  const int nitems = (MODE == 1) ? 1024 : 8192;
  for (int item = BID * 8 + w; item < nitems; item += GDIM * 8) {
    int g, row0, T, b, c = 0;
    if (MODE == 1) { g = item & 31; b = item >> 5; row0 = P_ROWS + b * 4; T = 4; }
    else { g = item & 31; c = (item >> 5) & 31; b = item >> 10; row0 = b * SEQ + c * 128; T = 128; }
    const int gi = layer * 32 + g; const int n = lane;
    const float are = abar[(gi * 64 + n) * 2], aim = abar[(gi * 64 + n) * 2 + 1];
    float hre = 0.f, him = 0.f;
    if (MODE == 1) {
      hre = p.in[6][((size_t)(layer * 32 + b) * 32 + g) * 64 + n];
      him = p.in[7][((size_t)(layer * 32 + b) * 32 + g) * 64 + n];
    }
    if (MODE == 2) {
      const float tre = abart[(gi * 64 + n) * 2], tim = abart[(gi * 64 + n) * 2 + 1];
      for (int jb = 0; jb < c; jb += 8) {
        float er[8], ei[8];
#pragma unroll
        for (int q = 0; q < 8; ++q) {
          er[q] = 0.f; ei[q] = 0.f;
          if (jb + q < c) { const float* ep = Eb + (((size_t)(b * 32 + jb + q) * 32 + g) * 128); er[q] = ep[n]; ei[q] = ep[64 + n]; }
        }
#pragma unroll
        for (int q = 0; q < 8; ++q) {
          if (jb + q < c) {
            float nr = tre * hre - tim * him + er[q], ni = tre * him + tim * hre + ei[q];
            hre = nr; him = ni;
          }
        }
      }
    }
    bf16x8 bmf[8];
    if (MODE != 2) {
      for (int nt = 0; nt < 8; ++nt) {
        bf16x8 z = {0, 0, 0, 0, 0, 0, 0, 0};
        if (fq < 2) z = *(const bf16x8*)(bmt + ((size_t)gi * 128 + 16 * nt + fr) * 16 + fq * 8);
        bmf[nt] = z;
      }
    }
    bf16x8 cmf[4];
    for (int ks = 0; ks < 4; ++ks) cmf[ks] = *(const bf16x8*)(cmt + ((size_t)gi * 16 + fr) * 128 + 32 * ks + fq * 8);
    const int nsc = (T + 15) >> 4;
    bf16x8 uf_next = {0, 0, 0, 0, 0, 0, 0, 0};
    if (MODE != 2) { if (fq < 2 && fr < T) uf_next = *(const bf16x8*)(ub + (size_t)(row0 + fr) * DH + g * 16 + fq * 8); }
    for (int sc = 0; sc < nsc; ++sc) {
      float ylv[4] = {0.f, 0.f, 0.f, 0.f}, ubv[4] = {0.f, 0.f, 0.f, 0.f};
      if (MODE != 0) {
#pragma unroll
        for (int v = 0; v < 4; ++v) {
          const int t = 16 * sc + 4 * fq + v;
          if (t < T) {
            const size_t idx = (size_t)(row0 + t) * DH + g * 16 + fr;
            ubv[v] = bf2f(ub[idx]);
            if (MODE == 2) ylv[v] = yl[idx];
          }
        }
      }
      if (MODE != 2) {
        const bf16x8 uf = uf_next;
        uf_next = (bf16x8){0, 0, 0, 0, 0, 0, 0, 0};
        if (sc + 1 < nsc && fq < 2 && (16 * (sc + 1) + fr) < T) uf_next = *(const bf16x8*)(ub + (size_t)(row0 + 16 * (sc + 1) + fr) * DH + g * 16 + fq * 8);
        for (int nt = 0; nt < 8; ++nt) {
          f32x4 r = __builtin_amdgcn_mfma_f32_16x16x32_bf16(uf, bmf[nt], (f32x4){0.f, 0.f, 0.f, 0.f}, 0, 0, 0);
          for (int v = 0; v < 4; ++v) bu[(4 * fq + v) * 132 + 16 * nt + fr] = r[v];
        }
        LDS_FENCE();
      }
      for (int t = 0; t < 16; ++t) {
        if (16 * sc + t < T) {
          float br = 0.f, bi = 0.f;
          if (MODE != 2) { br = bu[t * 132 + n]; bi = bu[t * 132 + 64 + n]; }
          float nr = are * hre - aim * him + br, ni = are * him + aim * hre + bi;
          hre = nr; him = ni;
        }
        hb[t * 136 + n] = f2bf(hre); hb[t * 136 + 64 + n] = f2bf(him);
      }
      LDS_FENCE();
      f32x4 y = {0.f, 0.f, 0.f, 0.f};
      for (int ks = 0; ks < 4; ++ks) {
        bf16x8 a = *(const bf16x8*)(hb + fr * 136 + 32 * ks + fq * 8);
        y = __builtin_amdgcn_mfma_f32_16x16x32_bf16(a, cmf[ks], y, 0, 0, 0);
      }
      for (int v = 0; v < 4; ++v) {
        int t = 16 * sc + 4 * fq + v;
        if (t < T) {
          size_t idx = (size_t)(row0 + t) * DH + g * 16 + fr;
          if (MODE == 0) yl[idx] = y[v];
          else {
            float yy = y[v] + dsk[g * 16 + fr] * ubv[v];
            if (MODE == 2) yy += ylv[v];
            zb[idx] = f2bf(gelu_tanh(yy));
          }
        }
      }
      LDS_FENCE();
    }
    if (MODE == 0) {
      float* ep = Eb + (((size_t)(b * 32 + c) * 32 + g) * 128);
      ep[n] = hre; ep[64 + n] = him;
    } else if (MODE == 1) {
      p.out[O_RS + ((size_t)(layer * 32 + b) * 32 + g) * 64 + n] = hre;
      p.out[O_IS + ((size_t)(layer * 32 + b) * 32 + g) * 64 + n] = him;
    } else {
      if (c == 31) {
        const float* ep = Eb + (((size_t)(b * 32 + 31) * 32 + g) * 128);
        p.out[O_RP + ((size_t)(layer * 8 + b) * 32 + g) * 64 + n] = hre + ep[n];
        p.out[O_IP + ((size_t)(layer * 8 + b) * 32 + g) * 64 + n] = him + ep[64 + n];
      }
    }
  }
}

__device__ void attn_merge_phase(const Params& p, int layer) {
  IDS(); unsigned char* const WS = launder_p(p.ws);
  const u16* ob = (const u16*)(WS + WS_O); const float* lseb = (const float*)(WS + WS_LSE);
  u16* mix = (u16*)(WS + WS_MIX);
  const float* gain = p.in[12] + layer * DH;
  const int lane = TID & 63; const int gw = BID * 8 + (TID >> 6); const int nw = GDIM * 8;
  const int h = lane >> 3;
  float gn[8];
  for (int j = 0; j < 8; ++j) gn[j] = gain[lane * 8 + j];
  for (int row = gw; row < M_ROWS; row += nw) {
    float w0 = 1.f, w1 = 0.f, w2 = 0.f;
    uint4 a0 = *(const uint4*)(ob + ((size_t)0 * M_PAD + row) * DH + lane * 8);
    uint4 a1 = make_uint4(0, 0, 0, 0), a2 = make_uint4(0, 0, 0, 0);
    if (row < P_ROWS) {
      const int b = row >> 12, sq = row & 4095;
      const float l0 = lseb[(size_t)((0 * 8 + h) * 8 + b) * SEQ + sq];
      const float l1 = lseb[(size_t)((1 * 8 + h) * 8 + b) * SEQ + (sq & 3) * (SEQ / 4) + (sq >> 2)];
      const float l2 = lseb[(size_t)((2 * 8 + h) * 8 + b) * SEQ + (sq & 15) * (SEQ / 16) + (sq >> 4)];
      const float m = fmaxf(l0, fmaxf(l1, l2));
      w0 = __expf(l0 - m); w1 = __expf(l1 - m); w2 = __expf(l2 - m);
      const float inv = __builtin_amdgcn_rcpf(w0 + w1 + w2); w0 *= inv; w1 *= inv; w2 *= inv;
      a1 = *(const uint4*)(ob + ((size_t)1 * M_PAD + row) * DH + lane * 8);
      a2 = *(const uint4*)(ob + ((size_t)2 * M_PAD + row) * DH + lane * 8);
    }
    unsigned x0[4] = {a0.x, a0.y, a0.z, a0.w}, x1[4] = {a1.x, a1.y, a1.z, a1.w}, x2[4] = {a2.x, a2.y, a2.z, a2.w};
    float v[8]; float ss = 0.f;
    for (int j = 0; j < 4; ++j) {
      v[2 * j] = w0 * bf2f((u16)(x0[j] & 0xffff)) + w1 * bf2f((u16)(x1[j] & 0xffff)) + w2 * bf2f((u16)(x2[j] & 0xffff));
      v[2 * j + 1] = w0 * bf2f((u16)(x0[j] >> 16)) + w1 * bf2f((u16)(x1[j] >> 16)) + w2 * bf2f((u16)(x2[j] >> 16));
      ss += v[2 * j] * v[2 * j] + v[2 * j + 1] * v[2 * j + 1];
    }
    ss = wave_sum(ss);
    float rs = rsqrtf(ss * (1.f / DH) + EPS);
    uint4 o;
    o.x = pk2(v[0] * rs * gn[0], v[1] * rs * gn[1]);
    o.y = pk2(v[2] * rs * gn[2], v[3] * rs * gn[3]);
    o.z = pk2(v[4] * rs * gn[4], v[5] * rs * gn[5]);
    o.w = pk2(v[6] * rs * gn[6], v[7] * rs * gn[7]);
    *(uint4*)(mix + (size_t)row * DM + lane * 8) = o;
  }
}

__device__ void ssm_norm_phase(const Params& p, int layer) {
  IDS(); unsigned char* const WS = launder_p(p.ws);
  const float* go = (const float*)(WS + WS_O);
  u16* mix = (u16*)(WS + WS_MIX);
  const float* gain = p.in[13] + layer * DH;
  const int lane = TID & 63; const int gw = BID * 8 + (TID >> 6); const int nw = GDIM * 8;
  float gn[8];
  for (int j = 0; j < 8; ++j) gn[j] = gain[lane * 8 + j];
  for (int row = gw; row < M_ROWS; row += nw) {
    const float4* rp = (const float4*)(go + (size_t)row * DH + lane * 8);
    float4 a = rp[0], b = rp[1];
    float v[8] = {a.x, a.y, a.z, a.w, b.x, b.y, b.z, b.w};
    float ss = 0.f;
    for (int j = 0; j < 8; ++j) ss += v[j] * v[j];
    ss = wave_sum(ss);
    float rs = rsqrtf(ss * (1.f / DH) + EPS);
    uint4 o;
    o.x = pk2(v[0] * rs * gn[0], v[1] * rs * gn[1]);
    o.y = pk2(v[2] * rs * gn[2], v[3] * rs * gn[3]);
    o.z = pk2(v[4] * rs * gn[4], v[5] * rs * gn[5]);
    o.w = pk2(v[6] * rs * gn[6], v[7] * rs * gn[7]);
    *(uint4*)(mix + (size_t)row * DM + DH + lane * 8) = o;
  }
}


#define XB_TMO      128
#define XB_XCNT(j)  (256  + 64 * (j))
#define XB_XSUB(j)  (1280 + 64 * (j))
#define XB_XGEN(j)  (2304 + 64 * (j))
#define XB_TOP      3328
#define XB_TOPGEN   3392
#define XCD_BAR_WORDS 3456
#define XB_SPIN_CAP (1u << 18)
__device__ __forceinline__ unsigned xb_ld(unsigned* p)              { return __hip_atomic_load(p, __ATOMIC_RELAXED, __HIP_MEMORY_SCOPE_AGENT); }
__device__ __forceinline__ unsigned xb_add(unsigned* p, unsigned v) { return __hip_atomic_fetch_add(p, v, __ATOMIC_RELAXED, __HIP_MEMORY_SCOPE_AGENT); }
__device__ __forceinline__ unsigned xb_xcc_id() { return (unsigned)__builtin_amdgcn_s_getreg((3 << 11) | 20) & 0xFu; }
#define XB_SPIN(cond, bar) do { unsigned _sp = 0; while (cond) { __builtin_amdgcn_s_sleep(1); \
    if ((++_sp & 255u) == 0u) { if (xb_ld(&(bar)[XB_TMO])) break; if (_sp > XB_SPIN_CAP) { atomicAdd(&(bar)[XB_TMO], 1u); break; } } } } while (0)
__device__ __forceinline__ void xcd_barrier_complete(unsigned* bar, unsigned x, unsigned& nloc, unsigned& nx) {
  const unsigned G = gridDim.x;
  unsigned sum, cnt, mine, sp = 0u;
  for (;;) {
    sum = 0u; cnt = 0u; mine = 0u;
#pragma unroll
    for (unsigned j = 0; j < 16; ++j) { const unsigned c = xb_ld(&bar[XB_XCNT(j)]); sum += c; cnt += (c > 0u) ? 1u : 0u; mine = (j == x) ? c : mine; }
    if (sum == G) break;
    __builtin_amdgcn_s_sleep(1);
    if ((++sp & 255u) == 0u) { if (xb_ld(&bar[XB_TMO])) break; if (sp > XB_SPIN_CAP) { atomicAdd(&bar[XB_TMO], 1u); break; } }
  }
  nloc = mine > 0u ? mine : 1u; nx = cnt > 0u ? cnt : 1u;
}
__device__ __forceinline__ void xcd_barrier(unsigned* bar, volatile LAS unsigned* st) {
  asm volatile("s_waitcnt vmcnt(0)" ::: "memory");
  __syncthreads();
  if (threadIdx.x == 0) {
    const unsigned x = xb_xcc_id();
    __builtin_amdgcn_s_waitcnt(0);
    unsigned nloc = st[0], nx = st[1];
    if (nloc == 0u) { xcd_barrier_complete(bar, x, nloc, nx); st[0] = nloc; st[1] = nx; }
    const unsigned old = xb_add(&bar[XB_XSUB(x)], 1u);
    const unsigned gen = old / nloc;
    if (old + 1u == (gen + 1u) * nloc) {
      __builtin_amdgcn_fence(__ATOMIC_RELEASE, "agent");
      asm volatile("s_waitcnt vmcnt(0)" ::: "memory");
      const unsigned og = xb_add(&bar[XB_TOP], 1u);
      const unsigned tg = og / nx;
      if (og + 1u == (tg + 1u) * nx) xb_add(&bar[XB_TOPGEN], 1u);
      else XB_SPIN(xb_ld(&bar[XB_TOPGEN]) == tg, bar);
      __builtin_amdgcn_fence(__ATOMIC_ACQUIRE, "agent");
      xb_add(&bar[XB_XGEN(x)], 1u);
      asm volatile("s_waitcnt vmcnt(0)" ::: "memory");
    } else {
      XB_SPIN(xb_ld(&bar[XB_XGEN(x)]) == gen, bar);
      __builtin_amdgcn_fence(__ATOMIC_ACQUIRE, "agent");
      asm volatile("s_waitcnt vmcnt(0)" ::: "memory");
    }
  }
  __syncthreads();
}

__global__ void __launch_bounds__(512, 2) fwd_megakernel(Params p) {
  cg::grid_group grid = cg::this_grid();
  __shared__ uint4 xb_words;
  volatile LAS unsigned* xst = (volatile LAS unsigned*)&xb_words;
  if (threadIdx.x == 0) { xst[0] = 0u; xst[1] = 0u; xst[2] = 0u; xst[3] = 0u; (void)xb_add(&((unsigned*)(p.ws + WS_BAR))[XB_XCNT(xb_xcc_id())], 1u); }
  __syncthreads();
  if (blockIdx.x == 0 && threadIdx.x == 0) {
    Params* d = (Params*)(p.ws + WS_PTRS);
#pragma unroll
    for (int i = 0; i < 32; ++i) d->in[i] = p.in[i];
    d->out = p.out; d->ws = p.ws;
  }
  convert_weights(p);
  make_tables(p);
  copy_cache(p);
  prenorm_phase(p.in[0], p.in[1], p.in[14], (u16*)(p.ws + WS_H), (float*)(p.ws + WS_RSS));
  pconv_phase(p, 0);
  grid.sync();

#pragma nounroll
  for (int ph = 0; ph < 22; ++ph) {
    const int layer = ph / 11, k = ph % 11;
    unsigned char* const ws = launder_p(p.ws);
    const Params& LP = *(const Params*)(ws + WS_PTRS);
    float* xbuf = (float*)(ws + WS_X);
    u16* hbuf = (u16*)(ws + WS_H);
    float* rss = (float*)(ws + WS_RSS) + (size_t)layer * 4 * M_PAD * 32;
    constexpr size_t RS = (size_t)M_PAD * 32;
    const u16* Wl = (const u16*)(ws + WS_W) + (size_t)layer * LW_SIZE;
    switch (k) {
      case 0: case 8: {
        EpiArgs ea{}; ea.b0 = (u16*)(ws + WS_ACT); ea.rss_in = rss + (k == 0 ? 0 : 2) * RS;
        const u16* A = (k == 0 && layer == 1) ? (const u16*)(ws + WS_MIX) : hbuf;
        gemm_phase<EPI_GU>(A, Wl + (k == 0 ? LW_GU0 : LW_GU1), DM, 2 * DFF, ea);
      } break;
      case 1: case 7: case 9: {
        EpiArgs ea{}; ea.xout = xbuf; ea.hout = hbuf;
        if (layer == 0 && k == 1) { ea.xp = LP.in[0]; ea.xs = LP.in[1]; } else { ea.xp = xbuf; ea.xs = xbuf + (size_t)P_ROWS * DM; }
        ea.scale = (k == 7) ? 1.0f : 0.5f;
        ea.rss_out = rss + (k == 1 ? 1 : (k == 7 ? 2 : 3)) * RS;
        ea.gain_out = (k == 1) ? LP.in[11] + layer * DM : (k == 7 ? LP.in[14] + (layer * 2 + 1) * DM : LP.in[28] + layer * DM);
        const u16* A = (k == 7) ? (const u16*)(ws + WS_MIX) : (const u16*)(ws + WS_ACT);
        const u16* B = Wl + (k == 1 ? LW_D0 : (k == 7 ? LW_OUT : LW_D1));
        gemm_phase<EPI_RES>(A, B, (k == 7) ? DM : DFF, DM, ea);
      } break;
      case 2: {
        EpiArgs ea{}; ea.out = LP.out; ea.layer = layer; ea.rss_in = rss + RS;
        ea.b0 = (u16*)(ws + WS_Q); ea.b1 = (u16*)(ws + WS_K); ea.b2 = (u16*)(ws + WS_V); ea.b3 = (u16*)(ws + WS_U);
        gemm_phase<EPI_QKVU>(hbuf, Wl + LW_IN, DM, DIN, ea);
      } break;
      case 3:
        attn_sample_phase(LP, layer);
        __syncthreads();
        attn_prompt_phase(LP, layer);
        s5_phase<0>(LP, layer);
        s5_phase<1>(LP, layer);
        break;
      case 4:
        s5_phase<2>(LP, layer);
        attn_merge_phase(LP, layer);
        break;
      case 5: {
        EpiArgs ea{}; ea.zin = (const u16*)(ws + WS_Z); ea.aux = LP.in[27] + layer * DH; ea.fout = (float*)(ws + WS_O);
        gemm_phase<EPI_GLU>((const u16*)(ws + WS_Z), Wl + LW_GLU, DH, DH, ea);
      } break;
      case 6:
        ssm_norm_phase(LP, layer);
        if (layer == 1) pconv_phase(LP, 1);
        break;
      default: {
        EpiArgs ea{}; ea.fout = (float*)(ws + WS_ACT);
        gemm_phase<EPI_PROJ>((const u16*)(ws + WS_PBF), Wl + LW_PP, DPLE, DM, ea);
        EpiArgs eb{}; eb.fin = (const float*)(ws + WS_ACT); eb.xout = xbuf; eb.rss_in = rss + 3 * RS;
        if (layer == 0) { eb.gain_out = LP.in[14] + 2 * DM; eb.hout = (u16*)(ws + WS_MIX); eb.rss_out = rss + 4 * RS; }
        gemm_phase<EPI_PLE>(hbuf, Wl + LW_PG, DM, DM, eb);
      } break;
    }
    xcd_barrier((unsigned*)(launder_p(p.ws) + WS_BAR), xst);
    if (k == 1 || k == 7 || k == 9 || (k == 10 && layer == 0)) {
      const float* gn = (k == 1) ? LP.in[11] + layer * DM : (k == 7 ? LP.in[14] + (layer * 2 + 1) * DM : (k == 9 ? LP.in[28] + layer * DM : LP.in[14] + 2 * DM));
      float* ro = rss + (k == 1 ? 1 : (k == 7 ? 2 : (k == 9 ? 3 : 4))) * RS;
      prenorm_phase(xbuf, xbuf + (size_t)P_ROWS * DM, gn, k == 10 ? (u16*)(ws + WS_MIX) : hbuf, ro, P_ROWS);
      xcd_barrier((unsigned*)(launder_p(p.ws) + WS_BAR), xst);
    }
  }
  final_norm_phase(*(const Params*)(launder_p(p.ws) + WS_PTRS));
}

extern "C" void kernel_launch(void* const* d_in, const int* in_sizes, int n_in, void* d_out, int out_size,
                              void* d_ws, size_t ws_size, hipStream_t stream) {
  static int grid_blocks = 0;
  if (!grid_blocks) {
    int dev = 0, cus = 0, per_cu = 0;
    (void)hipGetDevice(&dev);
    (void)hipDeviceGetAttribute(&cus, hipDeviceAttributeMultiprocessorCount, dev);
    (void)hipFuncSetAttribute((const void*)fwd_megakernel, hipFuncAttributeMaxDynamicSharedMemorySize, LDS_BYTES);
    (void)hipOccupancyMaxActiveBlocksPerMultiprocessor(&per_cu, (const void*)fwd_megakernel, 512, LDS_BYTES);
    if (per_cu < 1) per_cu = 1;
    grid_blocks = cus * per_cu;
    if (ws_size < WS_END) { fprintf(stderr, "workspace too small: %zu < %zu\n", ws_size, (size_t)WS_END); grid_blocks = -1; }
  }
  if (grid_blocks < 0) return;
  Params p{};
  for (int i = 0; i < 32; ++i) p.in[i] = (const float*)d_in[i];
  p.out = (float*)d_out; p.ws = (unsigned char*)d_ws;
  (void)hipMemsetAsync((char*)d_ws + WS_BAR, 0, 16384, stream);
  void* args[] = {&p};
  hipError_t e = hipLaunchCooperativeKernel((const void*)fwd_megakernel, dim3(grid_blocks), dim3(512), args, LDS_BYTES, stream);
  if (e != hipSuccess) fprintf(stderr, "cooperative launch failed: %s (grid %d)\n", hipGetErrorString(e), grid_blocks);
}
```
